# Optimizing an MI355X kernel written in HIP

```python
import jax, jax.numpy as jnp
from jax import lax
import numpy as np

D_MODEL = 1024
BATCH = 16
SEQ = 2048
DEPTH = 4

N_A_LAYERS = DEPTH // 2
N_B_LAYERS = DEPTH - N_A_LAYERS
CONV_WIDTH = 3
HEAD_DIM = 128
KV_HEADS = D_MODEL // HEAD_DIM
DILATION_GROUPS = ((128, 1), (512, 4), (2048, 16))
N_GROUPS = len(DILATION_GROUPS)
Q_HEADS = N_GROUPS * KV_HEADS
ATTN_WIDTH = KV_HEADS * HEAD_DIM
ROPE_DIMS = HEAD_DIM // 4
ROPE_THETA = 500000.0
PEER_HEADS = 8
PEER_N_KEYS = 128
PEER_N_EXPERTS = PEER_N_KEYS ** 2
PEER_KEY_DIM = 256
PEER_HALF = PEER_KEY_DIM // 2
PEER_TOPK = 16
PEER_SELECTED = PEER_HEADS * PEER_TOPK
PEER_TOKEN_BLOCK = 128
PLE_DIM = 256
NORM_EPS = 1e-6

kernel_name = "yoco_shortconv_dilated_attn_peer"


def rms_norm(x, gain):
    xf = x.astype(jnp.float32)
    y = xf * lax.rsqrt(jnp.mean(xf * xf, axis=-1, keepdims=True) + NORM_EPS)
    return (y * gain.astype(jnp.float32)).astype(x.dtype)


def rope_tables(positions):
    inv_freq = 1.0 / (ROPE_THETA ** (jnp.arange(0, ROPE_DIMS, 2, dtype=jnp.float32) / ROPE_DIMS))
    ang = positions.astype(jnp.float32)[..., None] * inv_freq
    return jnp.cos(ang), jnp.sin(ang)


def apply_partial_rope(x, cos, sin):
    half = ROPE_DIMS // 2
    xf = x.astype(jnp.float32)
    x1, x2, rest = xf[..., :half], xf[..., half:ROPE_DIMS], xf[..., ROPE_DIMS:]
    c, s = cos[:, :, None, :], sin[:, :, None, :]
    out = jnp.concatenate([x1 * c - x2 * s, x2 * c + x1 * s, rest], axis=-1)
    return out.astype(x.dtype)


def short_conv_mixer(h, w_in, conv_w, w_out):
    b_gate, c_gate, u = jnp.split(h @ w_in, 3, axis=-1)
    z = lax.conv_general_dilated(c_gate * u, conv_w[:, None, :], window_strides=(1,),
                                 padding=((CONV_WIDTH - 1, 0),),
                                 dimension_numbers=('NWC', 'WIO', 'NWC'),
                                 feature_group_count=D_MODEL)
    return (b_gate * z) @ w_out


def dilated_window_attention(q, k, v, window, dilation):
    bsz, seq, nh, dh = q.shape
    span = window // dilation
    blk = span
    unit = dilation * blk
    s_pad = -(-seq // unit) * unit
    nblk = s_pad // unit
    pad = ((0, 0), (0, s_pad - seq), (0, 0), (0, 0))

    def to_blocks(t):
        return jnp.pad(t, pad).reshape(bsz, nblk, blk, dilation, nh, dh)

    def with_prev(t):
        prev = jnp.concatenate([jnp.zeros_like(t[:, :1]), t[:, :-1]], axis=1)
        return jnp.concatenate([prev, t], axis=2)

    qb = to_blocks(q)
    kw, vw = with_prev(to_blocks(k)), with_prev(to_blocks(v))
    scores = jnp.einsum('bnqrhd,bnkrhd->bnrhqk', qb, kw,
                        preferred_element_type=jnp.float32) * (dh ** -0.5)
    qi = jnp.arange(blk)[:, None]
    ki = jnp.arange(2 * blk)[None, :]
    dist = qi + blk - ki
    n_idx = jnp.arange(nblk)[:, None, None]
    valid = (dist >= 0) & (dist <= span) & (n_idx * blk + ki[None] - blk >= 0)
    scores = jnp.where(valid[None, :, None, None], scores, -jnp.inf)
    m = jnp.max(scores, axis=-1, keepdims=True)
    e = jnp.exp(scores - m)
    den = jnp.sum(e, axis=-1, keepdims=True)
    o = jnp.einsum('bnrhqk,bnkrhd->bnqrhd', e / den, vw.astype(jnp.float32))
    lse = (m + jnp.log(den))[..., 0]
    o = o.reshape(bsz, s_pad, nh, dh)[:, :seq]
    lse = jnp.transpose(lse, (0, 1, 4, 2, 3)).reshape(bsz, s_pad, nh)[:, :seq]
    return o, lse


def dilated_attention_mixer(h, w_q, q_gain, w_o, k_shared, v_shared, cos, sin):
    bsz, seq, _ = h.shape
    q = (h @ w_q).reshape(bsz, seq, Q_HEADS, HEAD_DIM)
    q = apply_partial_rope(rms_norm(q, q_gain), cos, sin)
    q = q.reshape(bsz, seq, N_GROUPS, KV_HEADS, HEAD_DIM)
    outs, lses = [], []
    for g, (window, dilation) in enumerate(DILATION_GROUPS):
        o_g, lse_g = dilated_window_attention(q[:, :, g], k_shared, v_shared, window, dilation)
        outs.append(o_g)
        lses.append(lse_g)
    weights = jax.nn.softmax(jnp.stack(lses, axis=0), axis=0)
    o = jnp.sum(weights[..., None] * jnp.stack(outs, axis=0), axis=0)
    return o.reshape(bsz, seq, ATTN_WIDTH).astype(h.dtype) @ w_o


def shared_kv(x, kv_gain, w_kv, k_gain, cos, sin):
    bsz, seq, _ = x.shape
    k, v = jnp.split(rms_norm(x, kv_gain) @ w_kv, 2, axis=-1)
    k = k.reshape(bsz, seq, KV_HEADS, HEAD_DIM)
    v = v.reshape(bsz, seq, KV_HEADS, HEAD_DIM)
    k = apply_partial_rope(rms_norm(k, k_gain), cos, sin)
    return k, v


def peer_channel_mixer(h, w_q, sub_keys, u, v):
    bsz, seq, dm = h.shape
    n_tok = bsz * seq
    hf = h.reshape(n_tok, dm)
    q = (hf @ w_q).astype(jnp.float32).reshape(n_tok, PEER_HEADS, 2, PEER_HALF)
    sub = jnp.einsum('thpc,hpkc->thpk', q, sub_keys.astype(jnp.float32))
    top_s, top_i = lax.top_k(sub, PEER_TOPK)
    cand_s = (top_s[:, :, 0, :, None] + top_s[:, :, 1, None, :]).reshape(n_tok, PEER_HEADS, PEER_TOPK ** 2)
    cand_i = (top_i[:, :, 0, :, None] * PEER_N_KEYS + top_i[:, :, 1, None, :]).reshape(n_tok, PEER_HEADS, PEER_TOPK ** 2)
    best_s, best_pos = lax.top_k(cand_s, PEER_TOPK)
    expert_idx = jnp.take_along_axis(cand_i, best_pos, axis=-1)
    gates = jax.nn.softmax(best_s, axis=-1)
    n_blk = n_tok // PEER_TOKEN_BLOCK

    def token_block(args):
        xb, idx, g = args
        act = jnp.einsum('cd,ced->ce', xb, u[idx], preferred_element_type=jnp.float32)
        a = (g * jax.nn.gelu(act, approximate=False)).astype(xb.dtype)
        return jnp.einsum('ce,ced->cd', a, v[idx])

    y = lax.map(token_block, (hf.reshape(n_blk, PEER_TOKEN_BLOCK, dm),
                              expert_idx.reshape(n_blk, PEER_TOKEN_BLOCK, PEER_SELECTED),
                              gates.reshape(n_blk, PEER_TOKEN_BLOCK, PEER_SELECTED)))
    return y.reshape(bsz, seq, dm)


def setup_inputs(seed: int = 0) -> dict:
    key = jax.random.key(seed)
    ks = jax.random.split(key, 24)
    f32 = jnp.float32

    def w(k, shape, fan_in):
        return jax.random.normal(k, shape, f32) * (fan_in ** -0.5)

    def gain(k, shape):
        return 1.0 + 0.01 * jax.random.normal(k, shape, f32)

    offsets = jax.random.randint(ks[2], (BATCH, 1), 0, 4096, dtype=jnp.int32)
    positions = offsets + jnp.arange(SEQ, dtype=jnp.int32)[None, :]
    return {
        "x": jax.random.normal(ks[0], (BATCH, SEQ, D_MODEL), f32),
        "p": jax.random.normal(ks[1], (DEPTH, BATCH, SEQ, PLE_DIM), f32),
        "positions": positions,
        "a_norm": gain(ks[3], (N_A_LAYERS, D_MODEL)),
        "a_w_in": w(ks[4], (N_A_LAYERS, D_MODEL, 3 * D_MODEL), D_MODEL),
        "a_conv": w(ks[5], (N_A_LAYERS, CONV_WIDTH, D_MODEL), CONV_WIDTH),
        "a_w_out": w(ks[6], (N_A_LAYERS, D_MODEL, D_MODEL), D_MODEL),
        "kv_norm": gain(ks[7], (D_MODEL,)),
        "w_kv": w(ks[8], (D_MODEL, 2 * ATTN_WIDTH), D_MODEL),
        "k_norm": gain(ks[9], (HEAD_DIM,)),
        "b_norm": gain(ks[10], (N_B_LAYERS, D_MODEL)),
        "b_w_q": w(ks[11], (N_B_LAYERS, D_MODEL, Q_HEADS * HEAD_DIM), D_MODEL),
        "q_norm": gain(ks[12], (N_B_LAYERS, HEAD_DIM)),
        "b_w_o": w(ks[13], (N_B_LAYERS, ATTN_WIDTH, D_MODEL), ATTN_WIDTH),
        "ffn_norm": gain(ks[14], (DEPTH, D_MODEL)),
        "peer_w_q": w(ks[15], (DEPTH, D_MODEL, PEER_HEADS * PEER_KEY_DIM), D_MODEL),
        "peer_sub_keys": w(ks[16], (DEPTH, PEER_HEADS, 2, PEER_N_KEYS, PEER_HALF), PEER_HALF),
        "peer_u": w(ks[17], (DEPTH, PEER_N_EXPERTS, D_MODEL), D_MODEL),
        "peer_v": w(ks[18], (DEPTH, PEER_N_EXPERTS, D_MODEL), PEER_TOPK),
        "ple_norm": gain(ks[19], (DEPTH, D_MODEL)),
        "ple_w_gate": w(ks[20], (DEPTH, D_MODEL, D_MODEL), D_MODEL),
        "ple_w_proj": w(ks[21], (DEPTH, PLE_DIM, D_MODEL), PLE_DIM),
    }


def reference(x, p, positions, a_norm, a_w_in, a_conv, a_w_out, kv_norm, w_kv, k_norm,
              b_norm, b_w_q, q_norm, b_w_o, ffn_norm, peer_w_q, peer_sub_keys, peer_u,
              peer_v, ple_norm, ple_w_gate, ple_w_proj):
    cos, sin = rope_tables(positions)
    k_sh, v_sh = None, None
    for i in range(DEPTH):
        if i < N_A_LAYERS:
            x = x + short_conv_mixer(rms_norm(x, a_norm[i]), a_w_in[i], a_conv[i], a_w_out[i])
        else:
            j = i - N_A_LAYERS
            x = x + dilated_attention_mixer(rms_norm(x, b_norm[j]), b_w_q[j], q_norm[j], b_w_o[j],
                                            k_sh, v_sh, cos, sin)
        x = x + peer_channel_mixer(rms_norm(x, ffn_norm[i]), peer_w_q[i], peer_sub_keys[i],
                                   peer_u[i], peer_v[i])
        x = x + jax.nn.sigmoid(rms_norm(x, ple_norm[i]) @ ple_w_gate[i]) * (p[i] @ ple_w_proj[i])
        if i == N_A_LAYERS - 1:
            k_sh, v_sh = shared_kv(x, kv_norm, w_kv, k_norm, cos, sin)
    return x
```

```cpp
#include <hip/hip_runtime.h>
#include <hip/hip_cooperative_groups.h>
#include <cstdio>
#include <cstdint>
#include <cmath>
namespace pg8 {
#define PG8_LAS __attribute__((address_space(3)))
typedef unsigned short bf16_t;
typedef short bf16x8 __attribute__((ext_vector_type(8)));
typedef float f32x4 __attribute__((ext_vector_type(4)));
typedef unsigned u32x4 __attribute__((ext_vector_type(4)));
constexpr int BM = 256, BK = 64, HALF = 128, HTB = HALF * BK * 2  , STAGE_BYTES = 8 * HTB, NXCD = 8, WGM = 4;

__host__ __device__ __forceinline__ int lds_byte(int r, int c) { const int st = (r >> 4) * 2 + (c >> 5), rr = r & 15, cc = c & 31, ob = rr * 64 + cc * 2; return st * 1024 + (ob ^ (((ob >> 9) & 1) << 5)); }
__host__ __device__ __forceinline__ void stage_rc(int b, int& R, int& C) { const int st = b / 1024, sb = b % 1024, swz = sb ^ (((sb >> 9) & 1) << 5); R = (st >> 1) * 16 + swz / 64; C = (st & 1) * 32 + (swz % 64) / 2; }
__host__ __device__ __forceinline__ int perm32(int rho) { const int n = rho >> 4, i = rho & 15; return 8 * (i >> 2) + 4 * n + (i & 3); }

struct Unit { int pm, pn; };
struct Gemm { const bf16_t* A; const bf16_t* Bt; int M, N, K; };

struct StaticOrder {
    int nM, nN, nwg, G, c;
    __host__ __device__ void init(int M, int N, int G_, int c_) { nM = M / BM; nN = N / BM; nwg = nM * nN; G = G_; c = c_; }
    __host__ __device__ bool next(int i, Unit& u) const {
        const long L = (long)i * G + c; if (L >= nwg) return false;
        int wgid = (int)L; { const int q = nwg / NXCD, r = nwg % NXCD, xcd = wgid % NXCD, off = wgid / NXCD; wgid = (xcd < r ? xcd * (q + 1) : r * (q + 1) + (xcd - r) * q) + off; }
        const int nig = WGM * nN, gid = wgid / nig, fm = gid * WGM, gsz = (nM - fm) < WGM ? (nM - fm) : WGM;
        u.pm = fm + ((wgid % nig) % gsz); u.pn = (wgid % nig) / gsz; return true;
    }
    __device__ __forceinline__ void a_ready(const Unit&) const {}
    __device__ __forceinline__ void done(const Unit&) const {}
};

__device__ __forceinline__ unsigned cvt_pk_bf16(float lo, float hi) { unsigned r; asm volatile("v_cvt_pk_bf16_f32 %0, %1, %2" : "=v"(r) : "v"(lo), "v"(hi)); return r; }
typedef float f32x2 __attribute__((ext_vector_type(2)));
__device__ __forceinline__ f32x2 gelu_pk(f32x2 v) {
    const f32x2 av = __builtin_elementwise_abs(v), d = av * 0.2316418882f + 1.0f;
    f32x2 t; t.x = __builtin_amdgcn_rcpf(d.x); t.y = __builtin_amdgcn_rcpf(d.y);
    f32x2 q = t * 0.5307027145f + (-0.7265760135f); q = q * t + 0.7107068705f; q = q * t + (-0.142248368f); q = q * t + 0.127414796f; q = q * t;
    const f32x2 s = (v * v) * (-0.72134752044f);
    f32x2 e; e.x = __builtin_amdgcn_exp2f(s.x); e.y = __builtin_amdgcn_exp2f(s.y);
    const f32x2 m = v * (q * e), r = v - m;
    f32x2 o; o.x = v.x < 0.f ? m.x : r.x; o.y = v.y < 0.f ? m.y : r.y; return o;
}

template <int ACT  > struct EpiBf16 {
    static constexpr bool PERM = true, AFTER_DRAIN = false; static_assert(ACT == 0 || ACT == 1, "EpiBf16: ACT is 0 (none) or 1 (gelu_pk)");
    bf16_t* O; int ldc; const float* bias; int split_cols; size_t split_stride; float scale0;
    __device__ __forceinline__ void operator()(const f32x4 (&acc)[2][2][4][2], const Unit& u, int wr, int wc, int fr, int fq) const {
        const int row0 = u.pm * BM + wr * 64 + fr; int colt = u.pn * BM; bf16_t* base = O;
        float sc = 1.f; if (split_cols) { const int t = colt / split_cols; base += (size_t)t * split_stride; colt -= t * split_cols; if (t == 0) sc = scale0; }
        const int col0 = colt + wc * 32 + 8 * fq, bcol0 = u.pn * BM + wc * 32 + 8 * fq;
        f32x4 bv[2][2];
#pragma unroll
        for (int bj = 0; bj < 2; ++bj)
#pragma unroll
            for (int n = 0; n < 2; ++n) bv[bj][n] = bias ? *(const f32x4*)(bias + bcol0 + bj * HALF + 4 * n) : (f32x4){0.f, 0.f, 0.f, 0.f};
#pragma unroll
        for (int ai = 0; ai < 2; ++ai)
#pragma unroll
            for (int m = 0; m < 4; ++m) { bf16_t* rowp = base + (size_t)(row0 + ai * HALF + m * 16) * ldc + col0;
#pragma unroll
                for (int bj = 0; bj < 2; ++bj) { f32x4 v0 = acc[ai][bj][m][0] + bv[bj][0], v1 = acc[ai][bj][m][1] + bv[bj][1];
                    if (ACT == 1) { f32x2 a = gelu_pk((f32x2){v0[0], v0[1]}), b = gelu_pk((f32x2){v0[2], v0[3]}), c = gelu_pk((f32x2){v1[0], v1[1]}), d = gelu_pk((f32x2){v1[2], v1[3]});
                        v0 = (f32x4){a.x, a.y, b.x, b.y}; v1 = (f32x4){c.x, c.y, d.x, d.y}; }
                    v0 = v0 * sc; v1 = v1 * sc; u32x4 w; w.x = cvt_pk_bf16(v0[0], v0[1]); w.y = cvt_pk_bf16(v0[2], v0[3]); w.z = cvt_pk_bf16(v1[0], v1[1]); w.w = cvt_pk_bf16(v1[2], v1[3]);
                    *(u32x4*)(rowp + bj * HALF) = w; } }
    }
};
template <class Epi, class Sched, bool ALIGN_EPI = false, bool SP2 = false>
__device__ __forceinline__ void gemm_phase(PG8_LAS unsigned char* lds, const Gemm g, const Sched& S, const Epi& E) {
    int tid_l = threadIdx.x; asm volatile("" : "+v"(tid_l));
    const int tid = tid_l, wid = __builtin_amdgcn_readfirstlane(tid >> 6), lane = tid & 63, wr = wid >> 2, wc = wid & 3, fr = lane & 15, fq = lane >> 4;
    const int K = g.K, nt = K / BK;
    unsigned voffA[2], voffB[2];
#pragma unroll
    for (int i = 0; i < 2; ++i) { int R, C; stage_rc(tid * 16 + i * 8192, R, C); const int Rb = Epi::PERM ? ((R & ~31) + perm32(R & 31)) : R;
        voffA[i] = (unsigned)(R * K + C) * 2u; voffB[i] = (unsigned)(Rb * K + C) * 2u; }
    const size_t kstep = (size_t)(BK * 2);
    const size_t hstep = (size_t)HALF * K * 2;
    const size_t tstep = 2 * hstep;
    const unsigned ldsw = (unsigned)wid * 1024u;
    const int aoff = lds_byte(wr * 64 + fr, fq * 8), boff = lds_byte(wc * 32 + fr, fq * 8);
#define PG8_SA(b, h) (((b) * 2 + (h)) * HTB)
#define PG8_SB(b, h) ((4 + (b) * 2 + (h)) * HTB)
#define PG8_STAGE(bufoff, gbase, voff) do { _Pragma("unroll") for (int _i = 0; _i < 2; ++_i) \
        __builtin_amdgcn_global_load_lds((const unsigned*)((const char*)(gbase) + (voff)[_i]), (PG8_LAS unsigned*)(lds + (bufoff) + ldsw + _i * 8192), 16, 0, 0); } while (0)
#define PG8_LDA(dst, b, h) do { _Pragma("unroll") for (int m = 0; m < 4; ++m) _Pragma("unroll") for (int k = 0; k < 2; ++k) dst[m][k] = *(const PG8_LAS bf16x8*)(lds + PG8_SA(b, h) + aoff + m * 2048 + k * 1024); } while (0)
#define PG8_LDB(dst, b, h) do { _Pragma("unroll") for (int n = 0; n < 2; ++n) _Pragma("unroll") for (int k = 0; k < 2; ++k) dst[n][k] = *(const PG8_LAS bf16x8*)(lds + PG8_SB(b, h) + boff + n * 2048 + k * 1024); } while (0)
#define PG8_MMA(ai, bj, At, Bt) do { __builtin_amdgcn_s_setprio(1); _Pragma("unroll") for (int m = 0; m < 4; ++m) _Pragma("unroll") for (int n = 0; n < 2; ++n) _Pragma("unroll") for (int k = 0; k < 2; ++k) \
        acc[ai][bj][m][n] = __builtin_amdgcn_mfma_f32_16x16x32_bf16(Bt[n][k], At[m][k], acc[ai][bj][m][n], 0, 0, 0); __builtin_amdgcn_s_setprio(0); } while (0)
#define PG8_WAIT_V(n) asm volatile("s_waitcnt vmcnt(" #n ")" ::: "memory")
#define PG8_WAIT_L(n) asm volatile("s_waitcnt lgkmcnt(" #n ")" ::: "memory")
#define PG8_BAR __builtin_amdgcn_s_barrier()
#define PG8_SCHED __builtin_amdgcn_sched_barrier(0)
    Unit cur, nxt; int ui = 0;
    if (!S.next(0, cur)) return;
    f32x4 acc[2][2][4][2];
#pragma unroll
    for (int a = 0; a < 2; ++a)
#pragma unroll
        for (int b = 0; b < 2; ++b)
#pragma unroll
            for (int m = 0; m < 4; ++m)
#pragma unroll
                for (int n = 0; n < 2; ++n) acc[a][b][m][n] = (f32x4){0.f, 0.f, 0.f, 0.f};
    bf16x8 At[4][2], B0[2][2], B1[2][2];
    const char* cA = (const char*)g.A + (size_t)cur.pm * tstep; const char* cB = (const char*)g.Bt + (size_t)cur.pn * tstep;
    S.a_ready(cur);
    if constexpr (SP2) {
        PG8_STAGE(PG8_SB(0, 0), cB, voffB); PG8_STAGE(PG8_SB(0, 1), cB + hstep, voffB); PG8_STAGE(PG8_SA(0, 0), cA, voffA); PG8_STAGE(PG8_SA(0, 1), cA + hstep, voffA);
        if (wr == 1) PG8_BAR;
        PG8_WAIT_V(2); PG8_BAR;
        PG8_STAGE(PG8_SB(1, 0), cB + kstep, voffB); PG8_STAGE(PG8_SA(1, 0), cA + kstep, voffA); PG8_STAGE(PG8_SB(1, 1), cB + hstep + kstep, voffB);
        PG8_WAIT_V(6); PG8_BAR;
    } else {
        PG8_STAGE(PG8_SB(0, 0), cB, voffB); PG8_STAGE(PG8_SA(0, 0), cA, voffA); PG8_STAGE(PG8_SB(0, 1), cB + hstep, voffB); PG8_STAGE(PG8_SA(0, 1), cA + hstep, voffA);
        if (wr == 1) PG8_BAR;
        PG8_WAIT_V(4); PG8_BAR;
        PG8_STAGE(PG8_SB(1, 0), cB + kstep, voffB); PG8_STAGE(PG8_SA(1, 0), cA + kstep, voffA); PG8_STAGE(PG8_SB(1, 1), cB + hstep + kstep, voffB);
        PG8_WAIT_V(6); PG8_BAR;
    }
    for (;;) {
        const bool has_next = S.next(ui + 1, nxt);
        const char* nA = has_next ? (const char*)g.A + (size_t)nxt.pm * tstep : cA; const char* nB = has_next ? (const char*)g.Bt + (size_t)nxt.pn * tstep : cB;
        for (int t = 0; t < nt; t += 2) {
            const bool last = (t == nt - 2);
            const char* a1 = cA + (size_t)(t + 1) * kstep;
            const char* a2 = last ? nA : cA + (size_t)(t + 2) * kstep; const char* b2 = last ? nB : cB + (size_t)(t + 2) * kstep;
            const char* a3 = a2 + kstep; const char* b3 = b2 + kstep;
            if (last && has_next) S.a_ready(nxt);
            if constexpr (SP2) {
            PG8_LDB(B0, 0, 0); PG8_LDB(B1, 0, 1); PG8_SCHED; PG8_LDA(At, 0, 0); PG8_STAGE(PG8_SA(1, 1), a1 + hstep, voffA);
            PG8_WAIT_V(8); PG8_WAIT_L(0); PG8_BAR; PG8_MMA(0, 0, At, B0); PG8_MMA(0, 1, At, B1); PG8_BAR; PG8_SCHED;
            PG8_LDA(At, 0, 1); PG8_STAGE(PG8_SB(0, 0), b2, voffB); PG8_STAGE(PG8_SB(0, 1), b2 + hstep, voffB); PG8_STAGE(PG8_SA(0, 0), a2, voffA);
            PG8_WAIT_V(8); PG8_WAIT_L(0); PG8_BAR; PG8_MMA(1, 0, At, B0); PG8_MMA(1, 1, At, B1); PG8_BAR; PG8_SCHED;
            PG8_LDB(B0, 1, 0); PG8_LDB(B1, 1, 1); PG8_SCHED; PG8_LDA(At, 1, 0); PG8_STAGE(PG8_SA(0, 1), a2 + hstep, voffA);
            PG8_WAIT_V(8); PG8_WAIT_L(0); PG8_BAR; PG8_MMA(0, 0, At, B0); PG8_MMA(0, 1, At, B1); PG8_BAR; PG8_SCHED;
            PG8_LDA(At, 1, 1); PG8_STAGE(PG8_SB(1, 0), b3, voffB); PG8_STAGE(PG8_SB(1, 1), b3 + hstep, voffB); PG8_STAGE(PG8_SA(1, 0), a3, voffA);
            PG8_WAIT_V(8); PG8_WAIT_L(0); PG8_BAR; PG8_MMA(1, 0, At, B0); PG8_MMA(1, 1, At, B1); PG8_BAR; PG8_SCHED;
            } else {
            PG8_LDB(B0, 0, 0); PG8_SCHED; PG8_LDA(At, 0, 0); PG8_STAGE(PG8_SA(1, 1), a1 + hstep, voffA);
            PG8_WAIT_L(8); PG8_BAR; PG8_WAIT_L(0); PG8_MMA(0, 0, At, B0); PG8_BAR; PG8_SCHED;
            PG8_LDB(B1, 0, 1); PG8_STAGE(PG8_SB(0, 0), b2, voffB);
            PG8_BAR; PG8_WAIT_L(0); PG8_MMA(0, 1, At, B1); PG8_BAR;
            PG8_LDA(At, 0, 1); PG8_STAGE(PG8_SA(0, 0), a2, voffA);
            PG8_BAR; PG8_WAIT_L(0); PG8_MMA(1, 0, At, B0); PG8_BAR; PG8_SCHED;
            PG8_STAGE(PG8_SB(0, 1), b2 + hstep, voffB);
            PG8_WAIT_V(6); PG8_BAR; PG8_MMA(1, 1, At, B1); PG8_BAR;
            PG8_LDB(B0, 1, 0); PG8_SCHED; PG8_LDA(At, 1, 0); PG8_STAGE(PG8_SA(0, 1), a2 + hstep, voffA);
            PG8_WAIT_L(8); PG8_BAR; PG8_WAIT_L(0); PG8_MMA(0, 0, At, B0); PG8_BAR; PG8_SCHED;
            PG8_LDB(B1, 1, 1); PG8_STAGE(PG8_SB(1, 0), b3, voffB);
            PG8_BAR; PG8_WAIT_L(0); PG8_MMA(0, 1, At, B1); PG8_BAR;
            PG8_LDA(At, 1, 1); PG8_STAGE(PG8_SA(1, 0), a3, voffA);
            PG8_BAR; PG8_WAIT_L(0); PG8_MMA(1, 0, At, B0); PG8_BAR; PG8_SCHED;
            PG8_STAGE(PG8_SB(1, 1), b3 + hstep, voffB);
            PG8_WAIT_V(6); PG8_BAR; PG8_MMA(1, 1, At, B1); PG8_BAR;
            }
        }
        if constexpr (ALIGN_EPI) { if (wr == 0) PG8_BAR; }
        if constexpr (!Epi::AFTER_DRAIN) { E(acc, cur, wr, wc, fr, fq); S.done(cur); }
        if (!has_next) break;
#pragma unroll
        for (int a = 0; a < 2; ++a)
#pragma unroll
            for (int b = 0; b < 2; ++b)
#pragma unroll
                for (int m = 0; m < 4; ++m)
#pragma unroll
                    for (int n = 0; n < 2; ++n) acc[a][b][m][n] = (f32x4){0.f, 0.f, 0.f, 0.f};
        cur = nxt; cA = nA; cB = nB; ++ui;
        if constexpr (ALIGN_EPI) { if (wr == 1) PG8_BAR; }
    }
    PG8_WAIT_V(0);
    if constexpr (!ALIGN_EPI) { if (wr == 0) PG8_BAR; }
    PG8_BAR;
    if constexpr (Epi::AFTER_DRAIN) { E.fused(acc, cur, wr, wc, fr, fq, lds, wid, lane); S.done(cur); }
#undef PG8_SA
#undef PG8_SB
#undef PG8_STAGE
#undef PG8_LDA
#undef PG8_LDB
#undef PG8_MMA
#undef PG8_WAIT_V
#undef PG8_WAIT_L
#undef PG8_BAR
#undef PG8_SCHED
}
}

namespace pg8 {
struct EpiWin {
    static constexpr bool PERM = true, AFTER_DRAIN = false;
    bf16_t* Bo; bf16_t* CU;
    __device__ __forceinline__ void operator()(const f32x4 (&acc)[2][2][4][2], const Unit& u, int wr, int wc, int fr, int fq) const {
        const int row0 = u.pm * BM + wr * 64 + fr;
        if (u.pn < 4) {
            const int col0 = u.pn * BM + wc * 32 + 8 * fq;
#pragma unroll
            for (int ai = 0; ai < 2; ++ai)
#pragma unroll
                for (int m = 0; m < 4; ++m) { bf16_t* rowp = Bo + (size_t)(row0 + ai * HALF + m * 16) * 1024 + col0;
#pragma unroll
                    for (int bj = 0; bj < 2; ++bj) { const f32x4 v0 = acc[ai][bj][m][0], v1 = acc[ai][bj][m][1];
                        u32x4 w; w.x = cvt_pk_bf16(v0[0], v0[1]); w.y = cvt_pk_bf16(v0[2], v0[3]); w.z = cvt_pk_bf16(v1[0], v1[1]); w.w = cvt_pk_bf16(v1[2], v1[3]);
                        *(u32x4*)(rowp + bj * HALF) = w; } }
        } else {
            const int col0 = (u.pn - 4) * HALF + wc * 32 + 8 * fq;
#pragma unroll
            for (int ai = 0; ai < 2; ++ai)
#pragma unroll
                for (int m = 0; m < 4; ++m) { bf16_t* rowp = CU + (size_t)(row0 + ai * HALF + m * 16) * 1024 + col0;
                    const f32x4 v0 = acc[ai][0][m][0] * acc[ai][1][m][0], v1 = acc[ai][0][m][1] * acc[ai][1][m][1];
                    u32x4 w; w.x = cvt_pk_bf16(v0[0], v0[1]); w.y = cvt_pk_bf16(v0[2], v0[3]); w.z = cvt_pk_bf16(v1[0], v1[1]); w.w = cvt_pk_bf16(v1[2], v1[3]);
                    *(u32x4*)rowp = w; }
        }
    }
};
struct EpiF32 {
    static constexpr bool PERM = false, AFTER_DRAIN = false;
    const float* res; float* out; int ldc;
    __device__ __forceinline__ void operator()(const f32x4 (&acc)[2][2][4][2], const Unit& u, int wr, int wc, int fr, int fq) const {
        const int row0 = u.pm * BM + wr * 64 + fr, col0 = u.pn * BM + wc * 32 + 4 * fq;
#pragma unroll
        for (int ai = 0; ai < 2; ++ai)
#pragma unroll
            for (int m = 0; m < 4; ++m) { const size_t off = (size_t)(row0 + ai * HALF + m * 16) * ldc + col0;
#pragma unroll
                for (int bj = 0; bj < 2; ++bj)
#pragma unroll
                    for (int n = 0; n < 2; ++n) { const size_t p = off + bj * HALF + n * 16; f32x4 v = acc[ai][bj][m][n];
                        if (res) v += *(const f32x4*)(res + p);
                        *(f32x4*)(out + p) = v; } }
    }
};
__device__ __forceinline__ void unpack8(const u32x4& w, f32x4& lo, f32x4& hi) {
    lo[0] = __uint_as_float(w.x << 16); lo[1] = __uint_as_float(w.x & 0xffff0000u); lo[2] = __uint_as_float(w.y << 16); lo[3] = __uint_as_float(w.y & 0xffff0000u);
    hi[0] = __uint_as_float(w.z << 16); hi[1] = __uint_as_float(w.z & 0xffff0000u); hi[2] = __uint_as_float(w.w << 16); hi[3] = __uint_as_float(w.w & 0xffff0000u);
}
struct EpiResB {
    static constexpr bool PERM = true, AFTER_DRAIN = false;
    const bf16_t* xin; bf16_t* xout;
    __device__ __forceinline__ void operator()(const f32x4 (&acc)[2][2][4][2], const Unit& u, int wr, int wc, int fr, int fq) const {
        const int row0 = u.pm * BM + wr * 64 + fr, col0 = u.pn * BM + wc * 32 + 8 * fq;
#pragma unroll
        for (int ai = 0; ai < 2; ++ai)
#pragma unroll
            for (int m = 0; m < 4; ++m) { const size_t off = (size_t)(row0 + ai * HALF + m * 16) * 1024 + col0;
#pragma unroll
                for (int bj = 0; bj < 2; ++bj) { const size_t p = off + bj * HALF; f32x4 lo, hi; unpack8(*(const u32x4*)(xin + p), lo, hi);
                    lo += acc[ai][bj][m][0]; hi += acc[ai][bj][m][1];
                    u32x4 w; w.x = cvt_pk_bf16(lo[0], lo[1]); w.y = cvt_pk_bf16(lo[2], lo[3]); w.z = cvt_pk_bf16(hi[0], hi[1]); w.w = cvt_pk_bf16(hi[2], hi[3]);
                    *(u32x4*)(xout + p) = w; } }
    }
};
struct EpiPleB {
    static constexpr bool PERM = true, AFTER_DRAIN = false;
    const bf16_t* xin; bf16_t* xout; const bf16_t* P; float* outf;
    __device__ __forceinline__ void operator()(const f32x4 (&acc)[2][2][4][2], const Unit& u, int wr, int wc, int fr, int fq) const {
        const int row0 = u.pm * BM + wr * 64 + fr, col0 = u.pn * BM + wc * 32 + 8 * fq;
#pragma unroll
        for (int ai = 0; ai < 2; ++ai)
#pragma unroll
            for (int m = 0; m < 4; ++m) { const size_t off = (size_t)(row0 + ai * HALF + m * 16) * 1024 + col0;
#pragma unroll
                for (int bj = 0; bj < 2; ++bj) { const size_t p = off + bj * HALF; f32x4 lo, hi, pl, ph; unpack8(*(const u32x4*)(xin + p), lo, hi); unpack8(*(const u32x4*)(P + p), pl, ph);
                    const f32x4 a0 = acc[ai][bj][m][0], a1 = acc[ai][bj][m][1];
#pragma unroll
                    for (int e = 0; e < 4; ++e) { lo[e] += pl[e] / (1.0f + __expf(-a0[e])); hi[e] += ph[e] / (1.0f + __expf(-a1[e])); }
                    if (outf) { *(f32x4*)(outf + p) = lo; *(f32x4*)(outf + p + 4) = hi; }
                    else { u32x4 w; w.x = cvt_pk_bf16(lo[0], lo[1]); w.y = cvt_pk_bf16(lo[2], lo[3]); w.z = cvt_pk_bf16(hi[0], hi[1]); w.w = cvt_pk_bf16(hi[2], hi[3]);
                        *(u32x4*)(xout + p) = w; } } }
    }
};
}

namespace cg = cooperative_groups;
#define LAS __attribute__((address_space(3)))
typedef unsigned short bf16;
typedef unsigned u32x4 __attribute__((ext_vector_type(4)));
typedef unsigned u32x2 __attribute__((ext_vector_type(2)));
typedef float f32x4 __attribute__((ext_vector_type(4)));
typedef float f32x2 __attribute__((ext_vector_type(2)));
typedef short bf16x8 __attribute__((ext_vector_type(8)));
typedef short s16x4 __attribute__((ext_vector_type(4)));
typedef __bf16 bf16x2_t __attribute__((ext_vector_type(2)));

constexpr int BATCH = 16, SEQ = 2048, DM = 1024, T = BATCH * SEQ, DEPTH = 4;
constexpr float EPS = 1e-6f;
constexpr int NTHR = 512, NWV = 8;
constexpr int LDS_BYTES = 147456;
constexpr int NPHASES = 48;

constexpr size_t MiB = 1u << 20;
constexpr size_t WS_WIN = 2 * MiB, WS_WOUT = 14 * MiB, WS_WKV = 18 * MiB, WS_WQ = 22 * MiB, WS_WO = 34 * MiB, WS_WPQ = 38 * MiB, WS_WGATE = 54 * MiB, WS_WPROJ = 62 * MiB;
constexpr size_t WS_COS = 64 * MiB, WS_SIN = 66 * MiB, WS_IDX = 68 * MiB, WS_GATE = 84 * MiB, WS_H = 100 * MiB, WS_K = 164 * MiB, WS_V = 228 * MiB;
constexpr size_t WS_PB = 292 * MiB, WS_PBF = 356 * MiB, WS_BIG = 420 * MiB, WS_UBF = 676 * MiB, WS_VBF = 804 * MiB, WS_X = 932 * MiB, WS_END = 996 * MiB;

#define LDS_WAIT() asm volatile("s_waitcnt lgkmcnt(0)" ::: "memory")

__device__ __forceinline__ unsigned pk2(float lo, float hi) { f32x2 v = {lo, hi}; bf16x2_t b = __builtin_convertvector(v, bf16x2_t); return __builtin_bit_cast(unsigned, b); }
__device__ __forceinline__ float bflo(unsigned w) { return __uint_as_float(w << 16); }
__device__ __forceinline__ float bfhi(unsigned w) { return __uint_as_float(w & 0xffff0000u); }
__device__ __forceinline__ float dot2(unsigned a, unsigned b, float c) { return __builtin_amdgcn_fdot2_f32_bf16(__builtin_bit_cast(bf16x2_t, a), __builtin_bit_cast(bf16x2_t, b), c, false); }
__device__ __forceinline__ float wsum(float v) {
#pragma unroll
    for (int o = 1; o < 64; o <<= 1) v += __shfl_xor(v, o);
    return v;
}
__device__ __forceinline__ float wmaxf(float v) {
#pragma unroll
    for (int o = 1; o < 64; o <<= 1) v = fmaxf(v, __shfl_xor(v, o));
    return v;
}
__device__ __forceinline__ float gelu_erf(float x) { return 0.5f * x * (1.0f + erff(x * 0.70710678118654752f)); }

__device__ __forceinline__ int win_map(int n) { if (n < 1024) return n; const int ch = (n - 1024) & 1023, isu = (n >= 2048) ? 1 : 0; return 1024 + (ch >> 7) * 256 + isu * 128 + (ch & 127); }
__device__ __forceinline__ void transpose_item(const float* W, int K, int N, bf16* WT, int mode, LAS float* scr, int item, int lane) {
    const int nblk = N / 32, kb = item / nblk, nb = item % nblk, k0 = 64 * kb, n0 = 32 * nb;
#pragma unroll
    for (int i = 0; i < 8; ++i) { const int kk = 8 * i + (lane >> 3); const f32x4 v = *(const f32x4*)(W + (size_t)(k0 + kk) * N + n0 + 4 * (lane & 7));
        LAS float* d = scr + kk * 33 + 4 * (lane & 7); d[0] = v[0]; d[1] = v[1]; d[2] = v[2]; d[3] = v[3]; }
    LDS_WAIT();
    const int d0 = mode ? win_map(n0) : n0;
    const int c = lane & 7;
#pragma unroll
    for (int j = 0; j < 4; ++j) { const int n = (lane >> 3) + 8 * j; const LAS float* s = scr + (8 * c) * 33 + n;
        u32x4 o; o.x = pk2(s[0 * 33], s[1 * 33]); o.y = pk2(s[2 * 33], s[3 * 33]); o.z = pk2(s[4 * 33], s[5 * 33]); o.w = pk2(s[6 * 33], s[7 * 33]);
        *(u32x4*)(WT + (size_t)(d0 + n) * K + k0 + 8 * c) = o; }
    LDS_WAIT();
}
__device__ __forceinline__ void cvt_bulk(const float* src, bf16* dst, size_t n8, size_t gtid, size_t nthr) {
    size_t i = gtid;
    for (; i + 3 * nthr < n8; i += 4 * nthr) {
        f32x4 a[4], b[4];
#pragma unroll
        for (int u = 0; u < 4; ++u) { a[u] = ((const f32x4*)src)[2 * (i + u * nthr)]; b[u] = ((const f32x4*)src)[2 * (i + u * nthr) + 1]; }
#pragma unroll
        for (int u = 0; u < 4; ++u) { u32x4 o; o.x = pk2(a[u][0], a[u][1]); o.y = pk2(a[u][2], a[u][3]); o.z = pk2(b[u][0], b[u][1]); o.w = pk2(b[u][2], b[u][3]); ((u32x4*)dst)[i + u * nthr] = o; }
    }
    for (; i < n8; i += nthr) { const f32x4 a = ((const f32x4*)src)[2 * i], b = ((const f32x4*)src)[2 * i + 1];
        u32x4 o; o.x = pk2(a[0], a[1]); o.y = pk2(a[2], a[3]); o.z = pk2(b[0], b[1]); o.w = pk2(b[2], b[3]); ((u32x4*)dst)[i] = o; }
}
__device__ __forceinline__ void norm_rows(const float* Xf, const bf16* Xb, const bf16* Yadd, const float* gain, bf16* H, bf16* Xout, int gw, int NGW, int lane) {
    f32x4 gv[4];
#pragma unroll
    for (int j = 0; j < 2; ++j) { gv[2 * j] = *(const f32x4*)(gain + 512 * j + 8 * lane); gv[2 * j + 1] = *(const f32x4*)(gain + 512 * j + 8 * lane + 4); }
    for (int r = gw; r < T; r += NGW) {
        f32x4 v[4]; float s = 0.f;
#pragma unroll
        for (int j = 0; j < 2; ++j) { const size_t p = (size_t)r * DM + 512 * j + 8 * lane;
            if (Xf) { v[2 * j] = *(const f32x4*)(Xf + p); v[2 * j + 1] = *(const f32x4*)(Xf + p + 4); }
            else { const u32x4 w = *(const u32x4*)(Xb + p); v[2 * j] = (f32x4){bflo(w.x), bfhi(w.x), bflo(w.y), bfhi(w.y)}; v[2 * j + 1] = (f32x4){bflo(w.z), bfhi(w.z), bflo(w.w), bfhi(w.w)}; }
            if (Yadd) { const u32x4 w = *(const u32x4*)(Yadd + p); v[2 * j] += (f32x4){bflo(w.x), bfhi(w.x), bflo(w.y), bfhi(w.y)}; v[2 * j + 1] += (f32x4){bflo(w.z), bfhi(w.z), bflo(w.w), bfhi(w.w)}; } }
#pragma unroll
        for (int j = 0; j < 4; ++j) s += (v[j][0] * v[j][0] + v[j][1] * v[j][1]) + (v[j][2] * v[j][2] + v[j][3] * v[j][3]);
        s = wsum(s);
        const float rstd = 1.0f / sqrtf(s * (1.0f / DM) + EPS);
#pragma unroll
        for (int j = 0; j < 2; ++j) { const size_t p = (size_t)r * DM + 512 * j + 8 * lane; const f32x4 a = v[2 * j], b = v[2 * j + 1];
            if (Xout) { u32x4 w; w.x = pk2(a[0], a[1]); w.y = pk2(a[2], a[3]); w.z = pk2(b[0], b[1]); w.w = pk2(b[2], b[3]); *(u32x4*)(Xout + p) = w; }
            const f32x4 ga = gv[2 * j], gb = gv[2 * j + 1];
            u32x4 h; h.x = pk2(a[0] * rstd * ga[0], a[1] * rstd * ga[1]); h.y = pk2(a[2] * rstd * ga[2], a[3] * rstd * ga[3]);
            h.z = pk2(b[0] * rstd * gb[0], b[1] * rstd * gb[1]); h.w = pk2(b[2] * rstd * gb[2], b[3] * rstd * gb[3]);
            *(u32x4*)(H + p) = h; }
    }
}
__device__ __forceinline__ void precombine_item(const float* WQ, const float* SK, bf16* WPQ, LAS float* sk, int item, int tid, int wave, int lane) {
    const int layer = item >> 6, hp = (item >> 2) & 15, quarter = item & 3;
    const float* skg = SK + (size_t)(layer * 16 + hp) * 128 * 128;
    __syncthreads();
    for (int i = tid; i < 4096; i += NTHR) ((LAS f32x4*)sk)[i] = ((const f32x4*)skg)[i];
    __syncthreads();
    const int k = (quarter * 4 + (wave & 3)) * 64 + lane, key0 = (wave >> 2) * 64;
    const f32x4* wq = (const f32x4*)(WQ + ((size_t)layer * 1024 + k) * 2048 + hp * 128);
    f32x4 w[32];
#pragma unroll
    for (int c4 = 0; c4 < 32; ++c4) w[c4] = wq[c4];
    bf16* outp = WPQ + ((size_t)layer * 2048 + hp * 128) * 1024 + k;
    for (int key = key0; key < key0 + 64; ++key) {
        float a0 = 0.f, a1 = 0.f;
#pragma unroll
        for (int c4 = 0; c4 < 32; c4 += 2) { const f32x4 s0 = ((const LAS f32x4*)sk)[key * 32 + c4], s1 = ((const LAS f32x4*)sk)[key * 32 + c4 + 1];
            a0 += (w[c4][0] * s0[0] + w[c4][1] * s0[1]) + (w[c4][2] * s0[2] + w[c4][3] * s0[3]);
            a1 += (w[c4 + 1][0] * s1[0] + w[c4 + 1][1] * s1[1]) + (w[c4 + 1][2] * s1[2] + w[c4 + 1][3] * s1[3]); }
        outp[(size_t)key * 1024] = (bf16)(pk2(a0 + a1, 0.f) & 0xffffu);
    }
}

__device__ __forceinline__ void conv_gate(const bf16* Bg, const bf16* CU, const float* CW, bf16* Gout, size_t gtid, size_t nthr) {
    for (size_t i = gtid; i < (size_t)T * 128; i += nthr) {
        const int t = (int)(i >> 7), c8 = (int)(i & 127) * 8, s = t & (SEQ - 1);
        const size_t off = (size_t)t * DM + c8;
        const u32x4 bb = *(const u32x4*)(Bg + off), c0 = *(const u32x4*)(CU + off);
        u32x4 c1 = {0u, 0u, 0u, 0u}, c2 = {0u, 0u, 0u, 0u};
        if (s >= 1) c1 = *(const u32x4*)(CU + off - DM);
        if (s >= 2) c2 = *(const u32x4*)(CU + off - 2 * DM);
        float k0[8], k1[8], k2[8];
#pragma unroll
        for (int e = 0; e < 8; ++e) { k0[e] = CW[c8 + e]; k1[e] = CW[DM + c8 + e]; k2[e] = CW[2 * DM + c8 + e]; }
        unsigned ow[4];
#pragma unroll
        for (int q = 0; q < 4; ++q) {
            const float zl = k0[2 * q] * bflo(c2[q]) + k1[2 * q] * bflo(c1[q]) + k2[2 * q] * bflo(c0[q]);
            const float zh = k0[2 * q + 1] * bfhi(c2[q]) + k1[2 * q + 1] * bfhi(c1[q]) + k2[2 * q + 1] * bfhi(c0[q]);
            ow[q] = pk2(bflo(bb[q]) * zl, bfhi(bb[q]) * zh);
        }
        u32x4 o = {ow[0], ow[1], ow[2], ow[3]};
        *(u32x4*)(Gout + off) = o;
    }
}

__device__ __forceinline__ int f2s(float f) { const int b = __float_as_int(f); return b ^ ((b >> 31) & 0x7fffffff); }
__device__ __forceinline__ float s2f(int s) { return __int_as_float(s ^ ((s >> 31) & 0x7fffffff)); }
__device__ __forceinline__ void ins16(int (&l)[16], int x) {
#pragma unroll
    for (int i = 0; i < 16; ++i) { const int t = max(l[i], x); x = min(l[i], x); l[i] = t; }
}
__device__ __forceinline__ unsigned sel4(unsigned w0, unsigned w1, unsigned w2, unsigned w3, int i) { return (i & 2) ? ((i & 1) ? w3 : w2) : ((i & 1) ? w1 : w0); }
__device__ __forceinline__ void merge16(int (&o)[16], const int (&A)[16], const int (&B)[16]) {
#pragma unroll
    for (int i = 0; i < 16; ++i) o[i] = max(A[i], B[15 - i]);
#pragma unroll
    for (int st = 8; st >= 1; st >>= 1)
#pragma unroll
        for (int i = 0; i < 16; ++i) if ((i & st) == 0) { const int hi = max(o[i], o[i + st]), lo = min(o[i], o[i + st]); o[i] = hi; o[i + st] = lo; }
}
__device__ __forceinline__ void sort16_desc(int (&x)[16]) {
#pragma unroll
    for (int k = 2; k <= 16; k <<= 1)
#pragma unroll
        for (int j = k >> 1; j > 0; j >>= 1)
#pragma unroll
            for (int i = 0; i < 16; ++i) { const int l = i ^ j;
                if (l > i) { const int hi = max(x[i], x[l]), lo = min(x[i], x[l]); const bool desc = ((i & k) == 0) || (k == 16);
                    x[i] = desc ? hi : lo; x[l] = desc ? lo : hi; } }
}
__device__ __forceinline__ void topk_job(const bf16* base, size_t rstride, size_t item0, size_t istride, unsigned short* IDX, float* GATE, LAS unsigned char* wl, int lane) {
    {
        const bf16* gsrc = base + (size_t)(lane >> 3) * rstride + (lane & 7) * 8;
        int l1[16], l2[16];
#pragma unroll
        for (int i = 0; i < 16; ++i) { l1[i] = (int)0x80000000; l2[i] = (int)0x80000000; }
        u32x4 nx[8];
#pragma unroll
        for (int k = 0; k < 8; ++k) nx[k] = *(const u32x4*)(gsrc + (size_t)k * 8 * rstride);
#pragma unroll
        for (int p = 0; p < 2; ++p) {
            for (int cc = 0; cc < 2; ++cc) {
#pragma unroll
                for (int k = 0; k < 8; ++k) *(LAS u32x4*)(wl + ((lane >> 3) + 8 * k) * 144 + (lane & 7) * 16) = nx[k];
                const int cn = p * 2 + cc + 1;
                if (cn < 4) {
#pragma unroll
                    for (int k = 0; k < 8; ++k) nx[k] = *(const u32x4*)(gsrc + (size_t)k * 8 * rstride + cn * 64);
                }
                u32x4 v[8];
#pragma unroll
                for (int m = 0; m < 8; ++m) v[m] = *(const LAS u32x4*)(wl + lane * 144 + 16 * m);
                int kk[4][16], ta[16], tb[16];
#pragma unroll
                for (int j = 0; j < 64; ++j) { const unsigned w = v[j >> 3][(j >> 1) & 3]; const int bits = (int)((j & 1) ? (w & 0xffff0000u) : (w << 16));
                    kk[j >> 4][j & 15] = ((bits ^ ((bits >> 31) & 0x7fffffff)) & ~127) | (cc * 64 + j); }
                sort16_desc(kk[0]); sort16_desc(kk[1]); sort16_desc(kk[2]); sort16_desc(kk[3]);
                if (p == 0) { merge16(ta, l1, kk[0]); merge16(tb, ta, kk[1]); merge16(ta, tb, kk[2]); merge16(l1, ta, kk[3]); }
                else        { merge16(ta, l2, kk[0]); merge16(tb, ta, kk[1]); merge16(ta, tb, kk[2]); merge16(l2, ta, kk[3]); }
            }
        }
        float s1f[16], s2v[16];
#pragma unroll
        for (int i = 0; i < 16; ++i) { s1f[i] = s2f(l1[i] & ~127); s2v[i] = s2f(l2[i] & ~127); }
        int c0[16], c1[16], c2[16], cx[2];
        { int cnt = 0;
#pragma unroll
          for (int a = 0; a < 16; ++a)
#pragma unroll
            for (int b = 0; b < 16; ++b)
                if ((a + 1) * (b + 1) <= 16) { const int key = (f2s(s1f[a] + s2v[b]) & ~255) | (a << 4) | b;
                    if (cnt < 16) c0[cnt] = key; else if (cnt < 32) c1[cnt - 16] = key; else if (cnt < 48) c2[cnt - 32] = key; else cx[cnt - 48] = key;
                    ++cnt; } }
        sort16_desc(c0); sort16_desc(c1); sort16_desc(c2);
        int m01[16], l3[16];
        merge16(m01, c0, c1); merge16(l3, m01, c2);
        ins16(l3, cx[0]); ins16(l3, cx[1]);
#define PK4(L, q) ((unsigned)(L[4 * (q)] & 127) | ((unsigned)(L[4 * (q) + 1] & 127) << 8) | ((unsigned)(L[4 * (q) + 2] & 127) << 16) | ((unsigned)(L[4 * (q) + 3] & 127) << 24))
        const unsigned pa0 = PK4(l1, 0), pa1 = PK4(l1, 1), pa2 = PK4(l1, 2), pa3 = PK4(l1, 3), pb0 = PK4(l2, 0), pb1 = PK4(l2, 1), pb2 = PK4(l2, 2), pb3 = PK4(l2, 3);
#undef PK4
        float ex[16]; unsigned eidx[16]; float sum = 0.f;
        int l3max = l3[0];
#pragma unroll
        for (int i = 1; i < 16; ++i) l3max = max(l3max, l3[i]);
        const float vmax = s2f(l3max & ~255);
#pragma unroll
        for (int r = 0; r < 16; ++r) { const int bits = l3[r]; const int a = (bits >> 4) & 15, b = bits & 15;
            const unsigned i1 = (sel4(pa0, pa1, pa2, pa3, a >> 2) >> (8 * (a & 3))) & 127u, i2 = (sel4(pb0, pb1, pb2, pb3, b >> 2) >> (8 * (b & 3))) & 127u;
            eidx[r] = i1 * 128u + i2; ex[r] = __expf(s2f(bits & ~255) - vmax); sum += ex[r]; }
        const float inv = 1.0f / sum;
        const size_t item = item0 + (size_t)lane * istride;
        u32x4 o0, o1;
        o0.x = eidx[0] | (eidx[1] << 16); o0.y = eidx[2] | (eidx[3] << 16); o0.z = eidx[4] | (eidx[5] << 16); o0.w = eidx[6] | (eidx[7] << 16);
        o1.x = eidx[8] | (eidx[9] << 16); o1.y = eidx[10] | (eidx[11] << 16); o1.z = eidx[12] | (eidx[13] << 16); o1.w = eidx[14] | (eidx[15] << 16);
        *(u32x4*)(IDX + item * 16) = o0; *(u32x4*)(IDX + item * 16 + 8) = o1;
#pragma unroll
        for (int q = 0; q < 4; ++q) { f32x4 g = {ex[4 * q] * inv, ex[4 * q + 1] * inv, ex[4 * q + 2] * inv, ex[4 * q + 3] * inv}; *(f32x4*)(GATE + item * 16 + 4 * q) = g; }
    }
}

__device__ __forceinline__ void cvt_usl(const float* U, bf16* USL, int gw, int NGW, int lane) {
    for (int row = gw; row < DEPTH * 16384; row += NGW) {
        const int layer = row >> 14, e = row & 16383;
        const float* src = U + (size_t)row * 1024;
#pragma unroll
        for (int hf = 0; hf < 2; ++hf) { const int col = hf * 512 + 8 * lane; const f32x4 a = *(const f32x4*)(src + col), b = *(const f32x4*)(src + col + 4);
            u32x4 o; o.x = pk2(a[0], a[1]); o.y = pk2(a[2], a[3]); o.z = pk2(b[0], b[1]); o.w = pk2(b[2], b[3]);
            *(u32x4*)(USL + (((size_t)layer * 16 + (col >> 6)) * 16384 + e) * 64 + (col & 63)) = o; }
    }
}
#ifndef U_FP8
#define U_FP8 1
#endif
constexpr float U8_SCALE = 512.0f, U8_INV = 1.0f / 512.0f;
__device__ __forceinline__ void cvt_usl8(const float* U, unsigned char* USL8, int gw, int NGW, int lane) {
    int row = gw;
    for (; row + 3 * NGW < DEPTH * 16384; row += 4 * NGW) {
        f32x4 a[4][4];
#pragma unroll
        for (int u = 0; u < 4; ++u) { const float* src = U + (size_t)(row + u * NGW) * 1024 + 16 * lane;
#pragma unroll
            for (int q = 0; q < 4; ++q) a[u][q] = *(const f32x4*)(src + 4 * q); }
#pragma unroll
        for (int u = 0; u < 4; ++u) { const int rw = row + u * NGW, layer = rw >> 14, e = rw & 16383; u32x4 o;
#pragma unroll
            for (int q = 0; q < 4; ++q) { int w = 0;
                w = __builtin_amdgcn_cvt_pk_fp8_f32(a[u][q][0] * U8_SCALE, a[u][q][1] * U8_SCALE, w, false); w = __builtin_amdgcn_cvt_pk_fp8_f32(a[u][q][2] * U8_SCALE, a[u][q][3] * U8_SCALE, w, true); o[q] = (unsigned)w; }
            *(u32x4*)(USL8 + (((size_t)layer * 8 + (lane >> 3)) * 16384 + e) * 128 + 16 * (lane & 7)) = o; }
    }
    for (; row < DEPTH * 16384; row += NGW) {
        const int layer = row >> 14, e = row & 16383;
        const float* src = U + (size_t)row * 1024 + 16 * lane;
        u32x4 o;
#pragma unroll
        for (int q = 0; q < 4; ++q) { const f32x4 a = *(const f32x4*)(src + 4 * q); int w = 0;
            w = __builtin_amdgcn_cvt_pk_fp8_f32(a[0] * U8_SCALE, a[1] * U8_SCALE, w, false); w = __builtin_amdgcn_cvt_pk_fp8_f32(a[2] * U8_SCALE, a[3] * U8_SCALE, w, true); o[q] = (unsigned)w; }
        *(u32x4*)(USL8 + (((size_t)layer * 8 + (lane >> 3)) * 16384 + e) * 128 + 16 * (lane & 7)) = o;
    }
}
template <int CTRL> __device__ __forceinline__ float dpp_g(float v) { return __int_as_float(__builtin_amdgcn_update_dpp(0, __float_as_int(v), CTRL, 0xf, 0xf, true)); }
__device__ __forceinline__ void peer_s1_f8(const bf16* H, const unsigned short* IDXP, const unsigned char* USL8, unsigned short* PART, int bid, int G, int wave, int lane) {
    typedef _Float16 h16x2 __attribute__((ext_vector_type(2)));
    const int s = bid & 7, rank = bid >> 3, nr = (G - s + 7) >> 3;
    const int g8 = lane >> 3, li8 = lane & 7;
    const bool c0 = li8 & 1, c1 = li8 & 2, c2 = li8 & 4;
    const int i0 = (c2 ? 8 : 0) + (c0 ? 4 : 0) + (c1 ? 2 : 0);
    const unsigned char* ub = USL8 + (size_t)s * 16384 * 128;
    const unsigned lo16 = 16u * li8, seven = 7u;
    const int t0s = (rank * 8 + wave) * 2, stride = nr * 16;
    const int nit = (T - t0s + stride - 1) / stride;
    if (nit <= 0) return;
    u32x4 iw[2][2], hr[2][2], d[2][16]; h16x2 hp[8];
#define S1_LOAD_IH(q, tok) { const size_t t_ = (size_t)(tok); \
        iw[q][0] = *(const u32x4*)(IDXP + t_ * 128 + g8 * 16); iw[q][1] = *(const u32x4*)(IDXP + t_ * 128 + g8 * 16 + 8); \
        hr[q][0] = *(const u32x4*)(H + t_ * DM + 128 * s + 16 * li8); hr[q][1] = *(const u32x4*)(H + t_ * DM + 128 * s + 16 * li8 + 8); }
#define S1_ROWS(dst, src) _Pragma("unroll") for (int i = 0; i < 16; ++i) { const unsigned wd = (src)[i >> 3][(i >> 1) & 3]; unsigned off; \
        if (i & 1) asm("v_lshlrev_b32_sdwa %0, %1, %2 dst_sel:DWORD dst_unused:UNUSED_PAD src0_sel:DWORD src1_sel:WORD_1" : "=v"(off) : "v"(seven), "v"(wd)); \
        else       asm("v_lshlrev_b32_sdwa %0, %1, %2 dst_sel:DWORD dst_unused:UNUSED_PAD src0_sel:DWORD src1_sel:WORD_0" : "=v"(off) : "v"(seven), "v"(wd)); \
        dst[i] = *(const u32x4*)(ub + (off | lo16)); }
    S1_LOAD_IH(0, t0s) S1_LOAD_IH(1, t0s + 1)
    S1_ROWS(d[0], iw[0])
#pragma unroll
    for (int q = 0; q < 2; ++q) asm volatile("" :: "v"(iw[q][0]), "v"(iw[q][1]), "v"(hr[q][0]), "v"(hr[q][1]));
#pragma unroll
    for (int i = 0; i < 16; ++i) asm volatile("" :: "v"(d[0][i]));
    for (int j = 0; j < nit; ++j) {
        const int t0 = t0s + j * stride, tn = (j + 1 < nit) ? t0 + stride : t0;
#pragma unroll
        for (int p = 0; p < 2; ++p) {
#pragma unroll
            for (int q = 0; q < 4; ++q) { const unsigned w0 = hr[p][0][q], w1 = hr[p][1][q];
                hp[q] = (h16x2){(_Float16)bflo(w0), (_Float16)bfhi(w0)}; hp[4 + q] = (h16x2){(_Float16)bflo(w1), (_Float16)bfhi(w1)}; }
            __builtin_amdgcn_sched_barrier(0);
            S1_LOAD_IH(p, tn + p)
            S1_ROWS(d[p ^ 1], iw[p ^ 1])
            __builtin_amdgcn_sched_barrier(0);
            float a[16];
#pragma unroll
            for (int i = 0; i < 16; ++i) { float a0 = 0.f, a1 = 0.f;
#pragma unroll
                for (int q = 0; q < 4; ++q) { const unsigned dw = d[p][i][q];
                    a0 = __builtin_amdgcn_fdot2(__builtin_amdgcn_cvt_scalef32_pk_f16_fp8((int)dw, 1.0f, false), hp[2 * q], a0, false);
                    a1 = __builtin_amdgcn_fdot2(__builtin_amdgcn_cvt_scalef32_pk_f16_fp8((int)dw, 1.0f, true), hp[2 * q + 1], a1, false); }
                a[i] = a0 + a1; }
            float b[8], c[4], r[2];
#pragma unroll
            for (int k = 0; k < 8; ++k) { const float keep = c2 ? a[8 + k] : a[k], send = c2 ? a[k] : a[8 + k]; b[k] = keep + dpp_g<0x141>(send); }
#pragma unroll
            for (int k = 0; k < 4; ++k) { const float keep = c0 ? b[4 + k] : b[k], send = c0 ? b[k] : b[4 + k]; c[k] = keep + dpp_g<0xB1>(send); }
#pragma unroll
            for (int k = 0; k < 2; ++k) { const float keep = c1 ? c[2 + k] : c[k], send = c1 ? c[k] : c[2 + k]; r[k] = keep + dpp_g<0x4E>(send); }
            { const h16x2 pr = {(_Float16)r[0], (_Float16)r[1]}; *(unsigned*)(PART + ((size_t)s * T + t0 + p) * 128 + g8 * 16 + i0) = __builtin_bit_cast(unsigned, pr); }
        }
    }
#undef S1_LOAD_IH
#undef S1_ROWS
}
__device__ __forceinline__ void cvt_vsl(const float* V, bf16* VSL, int gw, int NGW, int lane) {
    for (int it = gw; it < DEPTH * 1024 * 4; it += NGW) {
        const int qq = it & 3, eb = (it >> 2) & 1023, layer = it >> 12;
        const float* src = V + ((size_t)layer * 16384 + eb * 16) * 1024 + qq * 256 + 4 * lane;
        u32x2 w[16];
#pragma unroll
        for (int e = 0; e < 16; ++e) { const f32x4 a = *(const f32x4*)(src + (size_t)e * 1024); w[e].x = pk2(a[0], a[1]); w[e].y = pk2(a[2], a[3]); }
        u32x4* dst = (u32x4*)(VSL + (((size_t)layer * 256 + qq * 64 + lane) * 16384 + eb * 16) * 4);
#pragma unroll
        for (int e = 0; e < 8; ++e) { u32x4 o = {w[2 * e].x, w[2 * e].y, w[2 * e + 1].x, w[2 * e + 1].y}; dst[e] = o; }
    }
}
#ifndef V_FP8
#define V_FP8 1
#endif
constexpr float V8_SCALE = 64.0f, V8_INV = 1.0f / 64.0f;
constexpr float A8_SCALE = 64.0f, A8_INV = 1.0f / 64.0f;
__device__ __forceinline__ void cvt_vsl8(const float* V, unsigned char* VSL8, int gw, int NGW, int lane) {
    for (int it = gw; it < DEPTH * 1024 * 2; it += NGW) {
        const int hf = it & 1, eb = (it >> 1) & 1023, layer = it >> 11;
        const float* src = V + ((size_t)layer * 16384 + eb * 16) * 1024 + hf * 512 + 8 * lane;
        u32x2 w[16];
#pragma unroll
        for (int e = 0; e < 16; ++e) { const f32x4 a = *(const f32x4*)(src + (size_t)e * 1024), b = *(const f32x4*)(src + (size_t)e * 1024 + 4); int w0 = 0, w1 = 0;
            w0 = __builtin_amdgcn_cvt_pk_fp8_f32(a[0] * V8_SCALE, a[1] * V8_SCALE, w0, false); w0 = __builtin_amdgcn_cvt_pk_fp8_f32(a[2] * V8_SCALE, a[3] * V8_SCALE, w0, true);
            w1 = __builtin_amdgcn_cvt_pk_fp8_f32(b[0] * V8_SCALE, b[1] * V8_SCALE, w1, false); w1 = __builtin_amdgcn_cvt_pk_fp8_f32(b[2] * V8_SCALE, b[3] * V8_SCALE, w1, true);
            w[e].x = (unsigned)w0; w[e].y = (unsigned)w1; }
        u32x4* dst = (u32x4*)(VSL8 + (((size_t)layer * 128 + hf * 64 + lane) * 16384 + eb * 16) * 8);
#pragma unroll
        for (int e = 0; e < 8; ++e) { u32x4 o = {w[2 * e].x, w[2 * e].y, w[2 * e + 1].x, w[2 * e + 1].y}; dst[e] = o; }
    }
}
__device__ __forceinline__ void peer_s1(const bf16* H, const unsigned short* IDXP, const bf16* USL, float* PART, int bid, int G, int wave, int lane) {
    const int x = bid & 7, rank = bid >> 3, nr = (G - x + 7) >> 3;
    const int g8 = lane >> 3, li8 = lane & 7;
    for (int sp = 0; sp < 2; ++sp) {
        const int s = 2 * x + sp;
        const unsigned char* ub = (const unsigned char*)(USL + (size_t)s * 16384 * 64) + li8 * 16;
        for (int t0 = (rank * 8 + wave) * 2; t0 < T; t0 += nr * 16) {
            u32x4 hs[2], iw[2][2], d[2][16];
#pragma unroll
            for (int tk = 0; tk < 2; ++tk) { const size_t t = (size_t)t0 + tk;
                hs[tk] = *(const u32x4*)(H + t * DM + 64 * s + 8 * li8);
                iw[tk][0] = *(const u32x4*)(IDXP + t * 128 + g8 * 16); iw[tk][1] = *(const u32x4*)(IDXP + t * 128 + g8 * 16 + 8); }
#pragma unroll
            for (int tk = 0; tk < 2; ++tk)
#pragma unroll
                for (int i = 0; i < 16; ++i) { const unsigned wd = iw[tk][i >> 3][(i >> 1) & 3]; const unsigned e = (i & 1) ? (wd >> 16) : (wd & 0xffffu);
                    d[tk][i] = *(const u32x4*)(ub + (size_t)(e * 128u)); }
#pragma unroll
            for (int tk = 0; tk < 2; ++tk) {
                float a[16];
#pragma unroll
                for (int i = 0; i < 16; ++i) { float v = dot2(d[tk][i][0], hs[tk][0], 0.f); v = dot2(d[tk][i][1], hs[tk][1], v); v = dot2(d[tk][i][2], hs[tk][2], v); a[i] = dot2(d[tk][i][3], hs[tk][3], v); }
                float b[8], c[4], r[2];
#pragma unroll
                for (int k = 0; k < 8; ++k) { const float keep = (li8 & 1) ? a[2 * k + 1] : a[2 * k], send = (li8 & 1) ? a[2 * k] : a[2 * k + 1]; b[k] = keep + __shfl_xor(send, 1); }
#pragma unroll
                for (int k = 0; k < 4; ++k) { const float keep = (li8 & 2) ? b[2 * k + 1] : b[2 * k], send = (li8 & 2) ? b[2 * k] : b[2 * k + 1]; c[k] = keep + __shfl_xor(send, 2); }
#pragma unroll
                for (int k = 0; k < 2; ++k) { const float keep = (li8 & 4) ? c[2 * k + 1] : c[2 * k], send = (li8 & 4) ? c[2 * k] : c[2 * k + 1]; r[k] = keep + __shfl_xor(send, 4); }
                float* pp = PART + ((size_t)s * T + t0 + tk) * 128 + g8 * 16 + li8;
                pp[0] = r[0]; pp[8] = r[1];
            }
        }
    }
}
__device__ __forceinline__ void peer_reduce(const unsigned short* PART, const float* GA, unsigned char* AO, size_t gtid, size_t nthr) {
    for (size_t i = gtid; i < (size_t)T * 32; i += nthr) {
        typedef _Float16 h16x2_r __attribute__((ext_vector_type(2)));
        f32x4 sum = {0.f, 0.f, 0.f, 0.f};
#pragma unroll
        for (int sl = 0; sl < 8; ++sl) { const u32x2 w = ((const u32x2*)(PART + (size_t)sl * T * 128))[i]; const unsigned w0 = w.x, w1 = w.y;
            const h16x2_r p0 = __builtin_bit_cast(h16x2_r, w0), p1 = __builtin_bit_cast(h16x2_r, w1);
            sum[0] += (float)p0[0]; sum[1] += (float)p0[1]; sum[2] += (float)p1[0]; sum[3] += (float)p1[1]; }
        f32x4 g = ((const f32x4*)GA)[i];
#pragma unroll
        for (int e = 0; e < 4; ++e) g[e] *= gelu_erf(U_FP8 ? sum[e] * U8_INV : sum[e]);
        { int w = 0; w = __builtin_amdgcn_cvt_pk_fp8_f32(fminf(fmaxf(g[0] * A8_SCALE, -448.f), 448.f), fminf(fmaxf(g[1] * A8_SCALE, -448.f), 448.f), w, false);
          w = __builtin_amdgcn_cvt_pk_fp8_f32(fminf(fmaxf(g[2] * A8_SCALE, -448.f), 448.f), fminf(fmaxf(g[3] * A8_SCALE, -448.f), 448.f), w, true); ((unsigned*)AO)[i] = (unsigned)w; }
    }
}
template <int CTRL> __device__ __forceinline__ float dpp_f(float v) { return __int_as_float(__builtin_amdgcn_update_dpp(0, __float_as_int(v), CTRL, 0xf, 0xf, true)); }
template <int ABL> __device__ __forceinline__ void peer_s2_f8(const unsigned short* IDXP, const unsigned char* AV, const unsigned char* VSL8, bf16* Y, LAS unsigned char* lds, int bid, int G, int tid, int wave, int lane) {
    typedef _Float16 h16x2 __attribute__((ext_vector_type(2)));
    const int tk = lane >> 2, jj = lane & 3;
    const bool b0 = jj & 1, b1 = jj & 2;
    constexpr int NIT = T / 2 / 16;
    const unsigned three = 3u, lbase = 0u;
    constexpr size_t STEP = (size_t)16 * NWV * 128;
    const int e0 = (b0 ? 4 : 0) + (b1 ? 2 : 0);
    for (int cb = bid; cb < 256; cb += G) {
        const int x = cb & 7, k = cb >> 3, c = 16 * x + (k & 15), th = k >> 4;
        __syncthreads();
        { const u32x4* src = (const u32x4*)(VSL8 + (size_t)c * 16384 * 8);
          for (int i = tid; i < 8192; i += NTHR) ((LAS u32x4*)lds)[i] = src[i]; }
        __syncthreads();
        const size_t tb = (size_t)th * (T / 2) + 16 * wave;
        const unsigned short* ip = IDXP + (tb + tk) * 128 + 32 * jj; const unsigned char* ap = AV + (tb + tk) * 128 + 32 * jj;
        bf16* yp = Y + (tb + tk) * DM + 8 * c + e0;
        u32x4 iw[2][4], aw[2][2]; u32x2 vb[2][8];
#define S2_LOOKUPS(dst, src) _Pragma("unroll") for (int m = 0; m < 8; ++m) { const unsigned wd = (src)[m >> 1]; unsigned ad; \
            if (m & 1) asm("v_lshlrev_b32_sdwa %0, %1, %2 dst_sel:DWORD dst_unused:UNUSED_PAD src0_sel:DWORD src1_sel:WORD_1" : "=v"(ad) : "v"(three), "v"(wd)); \
            else       asm("v_lshlrev_b32_sdwa %0, %1, %2 dst_sel:DWORD dst_unused:UNUSED_PAD src0_sel:DWORD src1_sel:WORD_0" : "=v"(ad) : "v"(three), "v"(wd)); \
            dst[m] = *(const LAS u32x2*)(uintptr_t)(ad + lbase); }
#pragma unroll
        for (int q = 0; q < 2; ++q) {
#pragma unroll
            for (int u = 0; u < 4; ++u) iw[q][u] = *(const u32x4*)(ip + q * STEP + 8 * u);
            aw[q][0] = *(const u32x4*)(ap + q * STEP); aw[q][1] = *(const u32x4*)(ap + q * STEP + 16); }
        S2_LOOKUPS(vb[0], iw[0][0])
#pragma unroll
        for (int q = 0; q < 2; ++q) {
#pragma unroll
            for (int u = 0; u < 4; ++u) asm volatile("" :: "v"(iw[q][u]));
            asm volatile("" :: "v"(aw[q][0]), "v"(aw[q][1])); }
        constexpr int NST = NIT / NWV;
        for (int s = 0; s < NST; s += 2) {
#pragma unroll
            for (int p = 0; p < 2; ++p) {
                const int sc = s + p;
                const size_t o2 = (size_t)(sc + 2 < NST ? sc + 2 : NST - 1) * STEP;
                h16x2 acc[4] = {{0, 0}, {0, 0}, {0, 0}, {0, 0}};
#pragma unroll
                for (int u = 0; u < 4; ++u) {
                    if (u < 3) { S2_LOOKUPS(vb[(u + 1) & 1], iw[p][u + 1]) } else { S2_LOOKUPS(vb[0], iw[p ^ 1][0]) }
                    if (u == 2) {
#pragma unroll
                        for (int u2 = 0; u2 < 4; ++u2) iw[p][u2] = *(const u32x4*)(ip + o2 + 8 * u2); }
                    __builtin_amdgcn_sched_barrier(0);
#pragma unroll
                    for (int m = 0; m < 8; ++m) { const u32x2 v = vb[u & 1][m];
                        const unsigned awd = aw[p][u >> 1][2 * (u & 1) + (m >> 2)];
                        const h16x2 ap2 = (m & 2) ? __builtin_amdgcn_cvt_scalef32_pk_f16_fp8((int)awd, 1.0f, true) : __builtin_amdgcn_cvt_scalef32_pk_f16_fp8((int)awd, 1.0f, false); const h16x2 am2 = (m & 1) ? (h16x2){ap2[1], ap2[1]} : (h16x2){ap2[0], ap2[0]};
                        acc[0] += am2 * __builtin_amdgcn_cvt_scalef32_pk_f16_fp8((int)v.x, 1.0f, false); acc[1] += am2 * __builtin_amdgcn_cvt_scalef32_pk_f16_fp8((int)v.x, 1.0f, true);
                        acc[2] += am2 * __builtin_amdgcn_cvt_scalef32_pk_f16_fp8((int)v.y, 1.0f, false); acc[3] += am2 * __builtin_amdgcn_cvt_scalef32_pk_f16_fp8((int)v.y, 1.0f, true); }
                    __builtin_amdgcn_sched_barrier(0);
                }
                aw[p][0] = *(const u32x4*)(ap + o2); aw[p][1] = *(const u32x4*)(ap + o2 + 16);
                float v8[8];
#pragma unroll
                for (int q = 0; q < 4; ++q) { v8[2 * q] = (float)acc[q][0]; v8[2 * q + 1] = (float)acc[q][1]; }
                float w4[4], w2[2];
#pragma unroll
                for (int k2 = 0; k2 < 4; ++k2) { const float keep = b0 ? v8[4 + k2] : v8[k2], send = b0 ? v8[k2] : v8[4 + k2]; w4[k2] = keep + dpp_f<0xB1>(send); }
#pragma unroll
                for (int k2 = 0; k2 < 2; ++k2) { const float keep = b1 ? w4[2 + k2] : w4[k2], send = b1 ? w4[k2] : w4[2 + k2]; w2[k2] = keep + dpp_f<0x4E>(send); }
                *(unsigned*)(yp + (size_t)sc * 16 * NWV * DM) = pk2(w2[0] * (V8_INV * A8_INV), w2[1] * (V8_INV * A8_INV));
            }
        }
#undef S2_LOOKUPS
    }
}

__device__ __forceinline__ void qk_norm_rope(bf16* buf, int ld, int nh, const float* gain, const float* COS, const float* SIN, float scale, int gw, int NGW, int lane, bool dry) {
    const int sub = lane >> 4, li = lane & 15;
    float gn[8];
#pragma unroll
    for (int e = 0; e < 8; ++e) gn[e] = gain[8 * li + e];
    const int total = T * nh;
    for (int base = gw * 4; base < total; base += NGW * 4) {
        const int pr = base + sub, t = pr / nh, h = pr - t * nh;
        bf16* p = buf + (size_t)t * ld + h * 128 + 8 * li;
        const u32x4 raw = *(const u32x4*)p;
        float x[8];
#pragma unroll
        for (int q = 0; q < 4; ++q) { x[2 * q] = bflo(raw[q]); x[2 * q + 1] = bfhi(raw[q]); }
        float ss = 0.f;
#pragma unroll
        for (int e = 0; e < 8; ++e) ss += x[e] * x[e];
        ss += __shfl_xor(ss, 1); ss += __shfl_xor(ss, 2); ss += __shfl_xor(ss, 4); ss += __shfl_xor(ss, 8);
        const float rstd = 1.0f / sqrtf(ss * (1.0f / 128.0f) + EPS);
        float yv[8], part[8];
#pragma unroll
        for (int e = 0; e < 8; ++e) yv[e] = x[e] * rstd * gn[e];
#pragma unroll
        for (int e = 0; e < 8; ++e) part[e] = __shfl_xor(yv[e], 2);
        if (li < 4) { const int jb = (li & 1) * 8;
#pragma unroll
            for (int e = 0; e < 8; ++e) { const float c = COS[(size_t)t * 16 + jb + e], s = SIN[(size_t)t * 16 + jb + e];
                yv[e] = (li < 2) ? (yv[e] * c - part[e] * s) : (yv[e] * c + part[e] * s); } }
        u32x4 o; o.x = pk2(yv[0] * scale, yv[1] * scale); o.y = pk2(yv[2] * scale, yv[3] * scale); o.z = pk2(yv[4] * scale, yv[5] * scale); o.w = pk2(yv[6] * scale, yv[7] * scale);
        if (!dry) *(u32x4*)p = o; else asm volatile("" :: "v"(o));
    }
}

constexpr int KROW = 272;
__device__ __forceinline__ s16x4 vtr(const LAS unsigned char* p) { typedef short v4i16_t __attribute__((ext_vector_type(4))); return __builtin_bit_cast(s16x4, __builtin_amdgcn_ds_read_tr16_b64_v4i16((LAS v4i16_t*)p)); }
__device__ __forceinline__ void att_decode(int it, int nblk, int& b, int& g, int& kvh, int& d, int& r, int& n) {
    int tile16, gb;
    if ((nblk & 7) == 0) { const int x = it & 7, q = it >> 3, P = 16 * x + q / 48, tt = q % 48; b = P >> 3; kvh = P & 7; g = tt >> 4; tile16 = tt & 15; }
    else { tile16 = it & 15; gb = it >> 7; kvh = (it >> 4) & 7; g = gb % 3; b = gb / 3; }
    if (g == 0) { d = 1; r = 0; n = tile16; } else if (g == 1) { d = 4; r = tile16 & 3; n = tile16 >> 2; } else { d = 16; r = tile16; n = 0; }
}
__device__ __forceinline__ void attn_phase(bf16* QO, const bf16* KB, const bf16* VB, float* LSE, const float* qgain, const float* COS, const float* SIN, LAS unsigned char* lds, int tid, int wave, int lane, int bid, int nblk, bool dry) {
    LAS unsigned char* Ks = lds; LAS unsigned char* Vs = lds + 256 * KROW;
    const int li = lane & 15, G = lane >> 4;
    const int tw = (wave & ~1) < 6 ? (wave & ~1) : 6;
    const float NEG = -INFINITY;
    const int qi = wave * 16 + li;
    const int kq = 16 * tw + 4 * G - qi;
    const LAS unsigned char* kbase = Ks + (16 * tw + li) * KROW + 16 * G;
    const LAS unsigned char* vbase = Vs + (16 * tw + 4 * G + (li >> 2)) * KROW + 8 * (li & 3);
    constexpr int NT = BATCH * 3 * 8 * 16;
    u32x4 kreg[8], vreg[8]; bf16x8 nqf[4]; f32x4 ncs[2], nsn[2];
    f32x4 qg[4][2];
#pragma unroll
    for (int s4 = 0; s4 < 4; ++s4) { qg[s4][0] = *(const f32x4*)(qgain + 32 * s4 + 8 * G); qg[s4][1] = *(const f32x4*)(qgain + 32 * s4 + 8 * G + 4); }
#define ATT_FETCH(B_, G_, KVH_, D_, R_, N_) do { _Pragma("unroll") for (int i_ = 0; i_ < 8; ++i_) { const int rr_ = (tid >> 4) + 32 * i_; \
        int s_ = (((N_) - 1) * 128 + rr_) * (D_) + (R_); s_ = s_ < 0 ? 0 : s_; const size_t off_ = ((size_t)(B_) * SEQ + s_) * 1024 + (KVH_) * 128 + (tid & 15) * 8; \
        kreg[i_] = *(const u32x4*)(KB + off_); vreg[i_] = *(const u32x4*)(VB + off_); } \
        { const int sq_ = ((N_) * 128 + qi) * (D_) + (R_); const size_t tq_ = (size_t)(B_) * SEQ + sq_; const bf16* qp_ = QO + tq_ * 3072 + (G_) * 1024 + (KVH_) * 128 + 8 * G; \
          _Pragma("unroll") for (int s4_ = 0; s4_ < 4; ++s4_) nqf[s4_] = *(const bf16x8*)(qp_ + 32 * s4_); \
          const int jb_ = (G & 1) * 8; ncs[0] = *(const f32x4*)(COS + tq_ * 16 + jb_); ncs[1] = *(const f32x4*)(COS + tq_ * 16 + jb_ + 4); nsn[0] = *(const f32x4*)(SIN + tq_ * 16 + jb_); nsn[1] = *(const f32x4*)(SIN + tq_ * 16 + jb_ + 4); } } while (0)
    int it = bid, b, g, kvh, d, r, n;
    if (it < NT) { att_decode(it, nblk, b, g, kvh, d, r, n); ATT_FETCH(b, g, kvh, d, r, n); }
    for (; it < NT; it += nblk) {
        const size_t rowb = (size_t)b * SEQ;
        const bool has_prev = n > 0;
        const int ltmin = has_prev ? 0 : (8 - tw);
        asm volatile("s_waitcnt lgkmcnt(0)\n\ts_barrier" ::: "memory");
#pragma unroll
        for (int i = 0; i < 8; ++i) { const int rr = (tid >> 4) + 32 * i;
            *(LAS u32x4*)(Ks + rr * KROW + (tid & 15) * 16) = kreg[i]; *(LAS u32x4*)(Vs + rr * KROW + (tid & 15) * 16) = vreg[i]; }
        const int sq = (n * 128 + qi) * d + r;
        bf16x8 qf[4];
#pragma unroll
        for (int s4 = 0; s4 < 4; ++s4) qf[s4] = nqf[s4];
        float cs[8], sn[8];
#pragma unroll
        for (int e = 0; e < 8; ++e) { cs[e] = ncs[e >> 2][e & 3]; sn[e] = nsn[e >> 2][e & 3]; }
        const int cg = g, ckvh = kvh;
        __builtin_amdgcn_sched_barrier(0);
        { const int itn = it + nblk, itc = itn < NT ? itn : it; att_decode(itc, nblk, b, g, kvh, d, r, n); ATT_FETCH(b, g, kvh, d, r, n); }
        __builtin_amdgcn_sched_barrier(0);
        {
            float qv[4][8]; float ss = 0.f;
#pragma unroll
            for (int s4 = 0; s4 < 4; ++s4) { const u32x4 w = __builtin_bit_cast(u32x4, qf[s4]);
#pragma unroll
                for (int q = 0; q < 4; ++q) { qv[s4][2 * q] = bflo(w[q]); qv[s4][2 * q + 1] = bfhi(w[q]); ss += qv[s4][2 * q] * qv[s4][2 * q] + qv[s4][2 * q + 1] * qv[s4][2 * q + 1]; } }
            ss += __shfl_xor(ss, 16); ss += __shfl_xor(ss, 32);
            const float rs = (1.0f / sqrtf(ss * (1.0f / 128.0f) + EPS));
#pragma unroll
            for (int s4 = 0; s4 < 4; ++s4) { const f32x4 g0 = qg[s4][0], g1 = qg[s4][1];
#pragma unroll
                for (int e = 0; e < 4; ++e) { qv[s4][e] *= rs * g0[e]; qv[s4][4 + e] *= rs * g1[e]; } }
#pragma unroll
            for (int e = 0; e < 8; ++e) { const float part = __shfl_xor(qv[0][e], 32);
                qv[0][e] = (G < 2) ? (qv[0][e] * cs[e] - part * sn[e]) : (qv[0][e] * cs[e] + part * sn[e]); }
            const float qs = 0.08838834764831845f * 1.4426950408889634f;
#pragma unroll
            for (int s4 = 0; s4 < 4; ++s4) { u32x4 w;
#pragma unroll
                for (int q = 0; q < 4; ++q) w[q] = pk2(qv[s4][2 * q] * qs, qv[s4][2 * q + 1] * qs);
                qf[s4] = __builtin_bit_cast(bf16x8, w); }
        }
        asm volatile("s_waitcnt lgkmcnt(0)\n\ts_barrier" ::: "memory");
        f32x4 st[10];
        int kqv = kq; asm volatile("" : "+v"(kqv));
#pragma unroll
        for (int lt = 0; lt < 10; ++lt) {
            if (lt >= ltmin) {
                f32x4 acc = {0.f, 0.f, 0.f, 0.f};
#pragma unroll
                for (int s4 = 0; s4 < 4; ++s4) { const bf16x8 kf = *(const LAS bf16x8*)(kbase + lt * 16 * KROW + 64 * s4); acc = __builtin_amdgcn_mfma_f32_16x16x32_bf16(kf, qf[s4], acc, 0, 0, 0); }
#pragma unroll
                for (int rg = 0; rg < 4; ++rg) { if ((unsigned)(kqv + 16 * lt + rg) > 128u) acc[rg] = NEG; }
                st[lt] = acc;
            } else { st[lt] = (f32x4){NEG, NEG, NEG, NEG}; }
        }
        float m = NEG;
#pragma unroll
        for (int lt = 0; lt < 10; ++lt) m = fmaxf(fmaxf(fmaxf(st[lt][0], st[lt][1]), fmaxf(st[lt][2], st[lt][3])), m);
        m = fmaxf(m, __shfl_xor(m, 16)); m = fmaxf(m, __shfl_xor(m, 32));
        float l = 0.f;
#pragma unroll
        for (int lt = 0; lt < 10; ++lt)
#pragma unroll
            for (int rg = 0; rg < 4; ++rg) { const float p = exp2f(st[lt][rg] - m); st[lt][rg] = p; l += p; }
        l += __shfl_xor(l, 16); l += __shfl_xor(l, 32);
        f32x4 o[8];
#pragma unroll
        for (int dt = 0; dt < 8; ++dt) o[dt] = (f32x4){0.f, 0.f, 0.f, 0.f};
#pragma unroll
        for (int pp = 0; pp < 5; ++pp) {
            if (2 * pp >= ltmin) {
                u32x4 aw; aw.x = pk2(st[2 * pp][0], st[2 * pp][1]); aw.y = pk2(st[2 * pp][2], st[2 * pp][3]); aw.z = pk2(st[2 * pp + 1][0], st[2 * pp + 1][1]); aw.w = pk2(st[2 * pp + 1][2], st[2 * pp + 1][3]);
                const bf16x8 pf = __builtin_bit_cast(bf16x8, aw);
#pragma unroll
                for (int dt = 0; dt < 8; ++dt) { const s16x4 lo = vtr(vbase + 2 * pp * 16 * KROW + 32 * dt), hi = vtr(vbase + (2 * pp + 1) * 16 * KROW + 32 * dt);
                    const bf16x8 vf = {lo[0], lo[1], lo[2], lo[3], hi[0], hi[1], hi[2], hi[3]};
                    o[dt] = __builtin_amdgcn_mfma_f32_16x16x32_bf16(vf, pf, o[dt], 0, 0, 0); }
            }
        }
        const float inv = 1.0f / l;
        bf16* op = QO + (rowb + sq) * 3072 + cg * 1024 + ckvh * 128 + 4 * G;
#pragma unroll
        for (int dt = 0; dt < 8; ++dt) { u32x2 ov; ov.x = pk2(o[dt][0] * inv, o[dt][1] * inv); ov.y = pk2(o[dt][2] * inv, o[dt][3] * inv);
            if (!dry) *(u32x2*)(op + 16 * dt) = ov; else asm volatile("" :: "v"(ov)); }
        if (G == 0 && !dry) LSE[((size_t)cg * T + rowb + sq) * 8 + ckvh] = m + log2f(l);
    }
#undef ATT_FETCH
}
__device__ __forceinline__ void merge_phase(const bf16* QO, const float* LSE, bf16* Hout, int gw, int NGW, int lane) {
    const int sub = lane >> 4, li = lane & 15;
    for (int base = gw * 4; base < T * 8; base += NGW * 4) {
        const int pr = base + sub, t = pr >> 3, h = pr & 7;
        const float l0 = LSE[((size_t)0 * T + t) * 8 + h], l1 = LSE[((size_t)1 * T + t) * 8 + h], l2 = LSE[((size_t)2 * T + t) * 8 + h];
        const float mx = fmaxf(l0, fmaxf(l1, l2));
        float w0 = exp2f(l0 - mx), w1 = exp2f(l1 - mx), w2 = exp2f(l2 - mx);
        const float inv = 1.0f / (w0 + w1 + w2); w0 *= inv; w1 *= inv; w2 *= inv;
        const bf16* p = QO + (size_t)t * 3072 + h * 128 + 8 * li;
        const u32x4 a = *(const u32x4*)p, bq = *(const u32x4*)(p + 1024), c = *(const u32x4*)(p + 2048);
        u32x4 o;
#pragma unroll
        for (int q = 0; q < 4; ++q) o[q] = pk2(w0 * bflo(a[q]) + w1 * bflo(bq[q]) + w2 * bflo(c[q]), w0 * bfhi(a[q]) + w1 * bfhi(bq[q]) + w2 * bfhi(c[q]));
        *(u32x4*)(Hout + (size_t)t * DM + h * 128 + 8 * li) = o;
    }
}

#define RLX_AGENT __ATOMIC_RELAXED, __HIP_MEMORY_SCOPE_AGENT
#define XB_TMO      128
#define XB_XCNT(j)  (256  + 64 * (j))
#define XB_XSUB(j)  (1280 + 64 * (j))
#define XB_XGEN(j)  (2304 + 64 * (j))
#define XB_TOP      3328
#define XB_TOPGEN   3392
#define XCD_BAR_WORDS 3456
#define XB_SPIN_CAP (1u << 20)

__device__ __forceinline__ unsigned xb_ld(unsigned* p)              { return __hip_atomic_load(p, __ATOMIC_RELAXED, __HIP_MEMORY_SCOPE_AGENT); }
__device__ __forceinline__ unsigned xb_add(unsigned* p, unsigned v) { return __hip_atomic_fetch_add(p, v, __ATOMIC_RELAXED, __HIP_MEMORY_SCOPE_AGENT); }
__device__ __forceinline__ unsigned xb_xcc_id() { return (unsigned)__builtin_amdgcn_s_getreg((3 << 11) | 20) & 0xFu; }
#define XB_SPIN(cond, bar) do { unsigned _sp = 0; while (cond) { __builtin_amdgcn_s_sleep(1); \
    if ((++_sp & 255u) == 0u) { if (xb_ld(&(bar)[XB_TMO])) break; if (_sp > XB_SPIN_CAP) { atomicAdd(&(bar)[XB_TMO], 1u); break; } } } } while (0)

struct XcdBarrier {
    unsigned* bar; unsigned x;
    volatile LAS unsigned* st;
};

__device__ __forceinline__ XcdBarrier xcd_barrier_post(unsigned* bar, volatile LAS unsigned* st) {
    XcdBarrier b; b.bar = bar; b.x = xb_xcc_id(); b.st = st;
    if (threadIdx.x == 0) (void)xb_add(&bar[XB_XCNT(b.x)], 1u);
    return b;
}
__device__ __forceinline__ void xcd_barrier_complete(unsigned* bar, unsigned x, unsigned& nloc, unsigned& nx) {
    const unsigned G = gridDim.x * gridDim.y * gridDim.z;
    unsigned sum, cnt, mine, sp = 0u;
    for (;;) {
        sum = 0u; cnt = 0u; mine = 0u;
#pragma unroll
        for (unsigned j = 0; j < 16; ++j) { const unsigned c = xb_ld(&bar[XB_XCNT(j)]); sum += c; cnt += (c > 0u) ? 1u : 0u; mine = (j == x) ? c : mine; }
        if (sum == G) break;
        __builtin_amdgcn_s_sleep(1);
        if ((++sp & 255u) == 0u) { if (xb_ld(&bar[XB_TMO])) break; if (sp > XB_SPIN_CAP) { atomicAdd(&bar[XB_TMO], 1u); break; } }
    }
    nloc = mine > 0u ? mine : 1u; nx = cnt > 0u ? cnt : 1u;
}

__device__ __forceinline__ void xcd_barrier(const XcdBarrier& b) {
    asm volatile("s_waitcnt vmcnt(0)" ::: "memory");
    __syncthreads();
    if (threadIdx.x == 0) {
        unsigned* bar = b.bar;
        __builtin_amdgcn_s_waitcnt(0);
        unsigned nloc = b.st[0], nx = b.st[1];
        if (nloc == 0u) { xcd_barrier_complete(bar, b.x, nloc, nx); b.st[0] = nloc; b.st[1] = nx; }
        const unsigned old = xb_add(&bar[XB_XSUB(b.x)], 1u);
        const unsigned gen = old / nloc;
        if (old + 1u == (gen + 1u) * nloc) {
            __builtin_amdgcn_fence(__ATOMIC_RELEASE, "agent");
            asm volatile("s_waitcnt vmcnt(0)" ::: "memory");
            const unsigned og = xb_add(&bar[XB_TOP], 1u);
            const unsigned tg = og / nx;
            if (og + 1u == (tg + 1u) * nx) xb_add(&bar[XB_TOPGEN], 1u);
            else XB_SPIN(xb_ld(&bar[XB_TOPGEN]) == tg, bar);
            __builtin_amdgcn_fence(__ATOMIC_ACQUIRE, "agent");
            xb_add(&bar[XB_XGEN(b.x)], 1u);
            asm volatile("s_waitcnt vmcnt(0)" ::: "memory");
        } else {
            XB_SPIN(xb_ld(&bar[XB_XGEN(b.x)]) == gen, bar);
            __builtin_amdgcn_fence(__ATOMIC_ACQUIRE, "agent");
            asm volatile("s_waitcnt vmcnt(0)" ::: "memory");
        }
    }
    __syncthreads();
}

#ifndef PHMASK
#define PHMASK 0xffffffffffffffffull
#endif
#ifndef PROBE_PRO
#define PROBE_PRO 0
#endif
#ifndef PROBE_ABL
#define PROBE_ABL 0
#endif
#ifndef PROBE_MASK
#define PROBE_MASK 0ull
#endif
struct Args { const void* in[22]; float* out; unsigned char* ws; int ph_lo, ph_hi; };
__device__ __forceinline__ const void* karg(int byte_off) {
    asm volatile("" : "+s"(byte_off));
    typedef const unsigned char __attribute__((address_space(4))) cuc4;
    cuc4* kp = (cuc4*)__builtin_amdgcn_kernarg_segment_ptr();
    return *(const void* const __attribute__((address_space(4)))*)(kp + byte_off);
}
#define INF(i) ((const float*)karg(8 * (i)))
#define XP() ((float*)karg(176))
#define WSB() ((unsigned char*)karg(184))

__global__ void __launch_bounds__(NTHR, 2) yoco_fwd(Args args) {
    extern __shared__ __attribute__((aligned(16))) unsigned char lds_raw[];
    LAS unsigned char* lds = (LAS unsigned char*)lds_raw;
    if ((unsigned)(uintptr_t)lds != 0u) __builtin_trap();
    volatile LAS unsigned* bst = (volatile LAS unsigned*)(lds + LDS_BYTES - 64);
    if (threadIdx.x < 16) bst[threadIdx.x] = 0u;
    __syncthreads();
    const XcdBarrier bar = xcd_barrier_post((unsigned*)WSB(), bst);
    int ph = 0; const int lo = args.ph_lo, hi = args.ph_hi;
#define TIDS int tid_l = threadIdx.x, bid_l = blockIdx.x, G_l = gridDim.x; asm volatile("" : "+v"(tid_l), "+s"(bid_l), "+s"(G_l)); \
             const int tid = tid_l, bid = bid_l, lane = tid & 63, wave = __builtin_amdgcn_readfirstlane(tid >> 6); const int G = G_l, gw = bid * NWV + wave, NGW = G * NWV; \
             const size_t gtid = (size_t)bid * NTHR + tid, nthr = (size_t)G * NTHR; (void)lane; (void)gw; (void)NGW; (void)gtid; (void)nthr; (void)bid;
#define PH_BEGIN(id) if (((PHMASK >> (id)) & 1ull) && ph >= lo && ph < hi) { for (int rep = (int)((PROBE_MASK >> (id)) & 1ull); rep >= 0; --rep) { const bool dry = rep > 0; (void)dry; if (PROBE_MASK) __syncthreads(); TIDS unsigned char* ws = WSB(); (void)ws;
#ifndef PROBE_BAR
#define PROBE_BAR 0
#endif
#define PH_END   } if (ph + 1 < hi) { xcd_barrier(bar); if (PROBE_BAR) { xcd_barrier(bar); xcd_barrier(bar); } } } ++ph;

    PH_BEGIN(0)
#if U_FP8
#define CVT_U_CALL cvt_usl8(INF(17), ws + WS_UBF, gw, NGW, lane);
#else
#define CVT_U_CALL cvt_usl(INF(17), (bf16*)(ws + WS_UBF), gw, NGW, lane);
#endif
#if V_FP8
#define CVT_V_CALL cvt_vsl8(INF(18), ws + WS_VBF, gw, NGW, lane);
#else
#define CVT_V_CALL cvt_vsl(INF(18), (bf16*)(ws + WS_VBF), gw, NGW, lane);
#endif
#define PRO_BODY \
    { \
        LAS float* scr = (LAS float*)(lds + wave * 8704); \
        bf16* WIN = (bf16*)(ws + WS_WIN); bf16* WOUT = (bf16*)(ws + WS_WOUT); bf16* WKV = (bf16*)(ws + WS_WKV); bf16* WQ = (bf16*)(ws + WS_WQ); bf16* WO = (bf16*)(ws + WS_WO); \
        bf16* WGATE = (bf16*)(ws + WS_WGATE); bf16* WPROJ = (bf16*)(ws + WS_WPROJ); \
 \
        constexpr int I_IN = 16 * 96, I_SQ = 16 * 32, I_KV = 16 * 64, I_PJ = 4 * 32; \
        constexpr int NITEMS = 2 * I_IN + 2 * I_SQ + I_KV + 2 * I_IN + 2 * I_SQ + 4 * I_SQ + 4 * I_PJ; \
        for (int it = gw; it < NITEMS; it += NGW) { \
            int r = it; \
            if (r < 2 * I_IN) { const int l = r / I_IN; transpose_item(INF(4) + (size_t)l * 1024 * 3072, 1024, 3072, WIN + (size_t)l * 3072 * 1024, 1, scr, r % I_IN, lane); continue; } r -= 2 * I_IN; \
            if (r < 2 * I_SQ) { const int l = r / I_SQ; transpose_item(INF(6) + (size_t)l * 1024 * 1024, 1024, 1024, WOUT + (size_t)l * 1024 * 1024, 0, scr, r % I_SQ, lane); continue; } r -= 2 * I_SQ; \
            if (r < I_KV) { transpose_item(INF(8), 1024, 2048, WKV, 0, scr, r, lane); continue; } r -= I_KV; \
            if (r < 2 * I_IN) { const int l = r / I_IN; transpose_item(INF(11) + (size_t)l * 1024 * 3072, 1024, 3072, WQ + (size_t)l * 3072 * 1024, 0, scr, r % I_IN, lane); continue; } r -= 2 * I_IN; \
            if (r < 2 * I_SQ) { const int l = r / I_SQ; transpose_item(INF(13) + (size_t)l * 1024 * 1024, 1024, 1024, WO + (size_t)l * 1024 * 1024, 0, scr, r % I_SQ, lane); continue; } r -= 2 * I_SQ; \
            if (r < 4 * I_SQ) { const int l = r / I_SQ; transpose_item(INF(20) + (size_t)l * 1024 * 1024, 1024, 1024, WGATE + (size_t)l * 1024 * 1024, 0, scr, r % I_SQ, lane); continue; } r -= 4 * I_SQ; \
            { const int l = r / I_PJ; transpose_item(INF(21) + (size_t)l * 256 * 1024, 256, 1024, WPROJ + (size_t)l * 1024 * 256, 0, scr, r % I_PJ, lane); } \
        } \
        for (int it = bid; it < 256; it += G) precombine_item(INF(15), INF(16), (bf16*)(ws + WS_WPQ), (LAS float*)lds, it, tid, wave, lane); \
        CVT_U_CALL \
        CVT_V_CALL \
        cvt_bulk(INF(1), (bf16*)(ws + WS_PBF), (size_t)DEPTH * T * 256 / 8, gtid, nthr); \
        { const int* pos_in = (const int*)karg(16); float* COS = (float*)(ws + WS_COS); float* SIN = (float*)(ws + WS_SIN); \
          for (size_t i = gtid; i < (size_t)T * 16; i += nthr) { \
            const int t = (int)(i >> 4), j = (int)(i & 15); \
            const double inv = exp(-(double)j * (13.122363377404328 / 16.0)); \
            const double ang = (double)pos_in[t] * inv; const double nn = rint(ang * 0.15915494309189535); \
            double rr = fma(-nn, 6.283185307179586, ang); rr = fma(-nn, 2.4492935982947064e-16, rr); \
            const float rf = (float)rr; COS[i] = cosf(rf); SIN[i] = sinf(rf); \
          } } \
        norm_rows(INF(0), nullptr, nullptr, INF(3), (bf16*)(ws + WS_H), (bf16*)(ws + WS_X), gw, NGW, lane); \
    }
    PRO_BODY
#if PROBE_PRO
    __syncthreads();
    PRO_BODY
#endif
    PH_END

    for (int layer = 0; layer < DEPTH; ++layer) {
        if (layer < 2) {
            PH_BEGIN(1)
            { pg8::Gemm g{(const bf16*)(ws + WS_H), (const bf16*)(ws + WS_WIN) + (size_t)layer * 3072 * 1024, T, 3072, 1024}; pg8::StaticOrder S; S.init(T, 3072, G, bid);
              pg8::EpiWin E{(bf16*)(ws + WS_BIG), (bf16*)(ws + WS_BIG + 64 * MiB)};
              pg8::gemm_phase<pg8::EpiWin, pg8::StaticOrder, true, true>(lds, g, S, E); }
            PH_END
            PH_BEGIN(2)
            conv_gate((const bf16*)(ws + WS_BIG), (const bf16*)(ws + WS_BIG + 64 * MiB), INF(5) + (size_t)layer * 3 * 1024, (bf16*)(ws + WS_BIG + 128 * MiB), gtid, nthr);
            PH_END
            PH_BEGIN(3)
            { bf16* X = (bf16*)(ws + WS_X);
              pg8::Gemm g{(const bf16*)(ws + WS_BIG + 128 * MiB), (const bf16*)(ws + WS_WOUT) + (size_t)layer * 1024 * 1024, T, 1024, 1024}; pg8::StaticOrder S; S.init(T, 1024, G, bid);
              pg8::EpiResB E{X, dry ? (bf16*)(ws + WS_K) : X};
              pg8::gemm_phase<pg8::EpiResB, pg8::StaticOrder, true, true>(lds, g, S, E); }
            PH_END
        } else {
            PH_BEGIN(4)
            { pg8::Gemm g{(const bf16*)(ws + WS_H), (const bf16*)(ws + WS_WQ) + (size_t)(layer - 2) * 3072 * 1024, T, 3072, 1024}; pg8::StaticOrder S; S.init(T, 3072, G, bid);
              pg8::EpiBf16<0> E{(bf16*)(ws + WS_BIG), 3072, nullptr, 0, 0, 1.f};
              pg8::gemm_phase<pg8::EpiBf16<0>, pg8::StaticOrder, true, true>(lds, g, S, E); }
            PH_END
            PH_BEGIN(6)
            attn_phase((bf16*)(ws + WS_BIG), (const bf16*)(ws + WS_K), (const bf16*)(ws + WS_V), (float*)(ws + WS_IDX), INF(12) + (size_t)(layer - 2) * 128, (const float*)(ws + WS_COS), (const float*)(ws + WS_SIN), lds, tid, wave, lane, bid, G, dry);
            PH_END
            PH_BEGIN(7)
            merge_phase((const bf16*)(ws + WS_BIG), (const float*)(ws + WS_IDX), (bf16*)(ws + WS_H), gw, NGW, lane);
            PH_END
            PH_BEGIN(8)
            { bf16* X = (bf16*)(ws + WS_X);
              pg8::Gemm g{(const bf16*)(ws + WS_H), (const bf16*)(ws + WS_WO) + (size_t)(layer - 2) * 1024 * 1024, T, 1024, 1024}; pg8::StaticOrder S; S.init(T, 1024, G, bid);
              pg8::EpiResB E{X, dry ? (bf16*)(ws + WS_BIG) : X};
              pg8::gemm_phase<pg8::EpiResB, pg8::StaticOrder, true, true>(lds, g, S, E); }
            PH_END
        }
        PH_BEGIN(9)
        norm_rows(nullptr, (const bf16*)(ws + WS_X), nullptr, INF(14) + (size_t)layer * 1024, (bf16*)(ws + WS_H), nullptr, gw, NGW, lane);
        PH_END
        PH_BEGIN(10)
        { pg8::Gemm g{(const bf16*)(ws + WS_H), (const bf16*)(ws + WS_WPQ) + (size_t)layer * 2048 * 1024, T, 2048, 1024}; pg8::StaticOrder S; S.init(T, 2048, G, bid);
          pg8::EpiBf16<0> E{(bf16*)(ws + WS_BIG), 2048, nullptr, 0, 0, 1.f};
          pg8::gemm_phase<pg8::EpiBf16<0>, pg8::StaticOrder, true, true>(lds, g, S, E);
          asm volatile("s_waitcnt vmcnt(0)" ::: "memory"); __syncthreads();
          int lane2 = threadIdx.x & 63, wave2 = wave, bid2 = bid; asm volatile("" : "+v"(lane2), "+s"(wave2), "+s"(bid2));
          unsigned char* ws2 = WSB();
          constexpr int NWG = (T / 256) * 8;
          const int nu = (NWG - bid2 + G - 1) / G;
          for (int jb = wave2; jb < 4 * nu; jb += NWV) {
              int wgid = (jb >> 2) * G + bid2; { const int q = NWG / 8, xcd = wgid % 8, off = wgid / 8; wgid = xcd * q + off; }
              const int nig = pg8::WGM * 8, gid = wgid / nig, fm = gid * pg8::WGM, pm = fm + ((wgid % nig) % pg8::WGM), pn = (wgid % nig) / pg8::WGM;
              const size_t t0 = (size_t)pm * 256 + 64 * (jb & 3);
              topk_job((const bf16*)(ws2 + WS_BIG) + t0 * 2048 + pn * 256, 2048, t0 * 8 + pn, 8, (unsigned short*)(ws2 + WS_IDX), (float*)(ws2 + WS_GATE), lds + wave2 * 10240, lane2); } }
        PH_END
        PH_BEGIN(12)
#if U_FP8
        peer_s1_f8((const bf16*)(ws + WS_H), (const unsigned short*)(ws + WS_IDX), ws + WS_UBF + (size_t)layer * 16384 * 1024, (unsigned short*)(ws + WS_BIG), bid, G, wave, lane);
#else
        peer_s1((const bf16*)(ws + WS_H), (const unsigned short*)(ws + WS_IDX), (const bf16*)(ws + WS_UBF) + (size_t)layer * 16384 * 1024, (float*)(ws + WS_BIG), bid, G, wave, lane);
#endif
        PH_END
        PH_BEGIN(18)
        peer_reduce((const unsigned short*)(ws + WS_BIG), (const float*)(ws + WS_GATE), dry ? (unsigned char*)(ws + WS_PB) : (unsigned char*)(ws + WS_IDX + 8 * MiB), gtid, nthr);
        { pg8::Gemm g{(const bf16*)(ws + WS_PBF) + (size_t)layer * T * 256, (const bf16*)(ws + WS_WPROJ) + (size_t)layer * 1024 * 256, T, 1024, 256}; pg8::StaticOrder S; S.init(T, 1024, G, bid);
          pg8::EpiBf16<0> E{(bf16*)(ws + WS_PB), 1024, nullptr, 0, 0, 1.f};
          pg8::gemm_phase<pg8::EpiBf16<0>, pg8::StaticOrder, true, true>(lds, g, S, E); }
        PH_END
        PH_BEGIN(19)
        if (PROBE_ABL != 0 && dry) peer_s2_f8<PROBE_ABL>((const unsigned short*)(ws + WS_IDX), (const unsigned char*)(ws + WS_IDX + 8 * MiB), ws + WS_VBF + (size_t)layer * 16384 * 1024, (bf16*)(ws + WS_BIG + 128 * MiB), lds, bid, G, tid, wave, lane);
        else peer_s2_f8<0>((const unsigned short*)(ws + WS_IDX), (const unsigned char*)(ws + WS_IDX + 8 * MiB), ws + WS_VBF + (size_t)layer * 16384 * 1024, (bf16*)(ws + WS_BIG), lds, bid, G, tid, wave, lane);
        PH_END
        PH_BEGIN(20)
        { bf16* X = (bf16*)(ws + WS_X); norm_rows(nullptr, X, (const bf16*)(ws + WS_BIG), INF(19) + (size_t)layer * 1024, (bf16*)(ws + WS_H), dry ? (bf16*)(ws + WS_BIG + 128 * MiB) : X, gw, NGW, lane); }
        PH_END
        PH_BEGIN(13)
        { pg8::Gemm g{(const bf16*)(ws + WS_H), (const bf16*)(ws + WS_WGATE) + (size_t)layer * 1024 * 1024, T, 1024, 1024}; pg8::StaticOrder S; S.init(T, 1024, G, bid);
          bf16* X = (bf16*)(ws + WS_X);
          pg8::EpiPleB E{X, dry ? (bf16*)(ws + WS_BIG) : X, (const bf16*)(ws + WS_PB), (layer == DEPTH - 1) ? (dry ? (float*)(ws + WS_BIG) : XP()) : nullptr};
          pg8::gemm_phase<pg8::EpiPleB, pg8::StaticOrder, true, true>(lds, g, S, E); }
        PH_END
        if (layer < 3) {
            PH_BEGIN(14)
            { const float* gn = (layer == 0) ? (INF(3) + 1024) : (layer == 1) ? INF(7) : (INF(10) + 1024);
              norm_rows(nullptr, (const bf16*)(ws + WS_X), nullptr, gn, (bf16*)(ws + WS_H), nullptr, gw, NGW, lane); }
            PH_END
        }
        if (layer == 1) {
            PH_BEGIN(15)
            { pg8::Gemm g{(const bf16*)(ws + WS_H), (const bf16*)(ws + WS_WKV), T, 2048, 1024}; pg8::StaticOrder S; S.init(T, 2048, G, bid);
              pg8::EpiBf16<0> E{(bf16*)(ws + WS_K), 1024, nullptr, 1024, (size_t)(WS_V - WS_K) / 2, 1.f};
              pg8::gemm_phase<pg8::EpiBf16<0>, pg8::StaticOrder, true, true>(lds, g, S, E); }
            PH_END
            PH_BEGIN(16)
            qk_norm_rope((bf16*)(ws + WS_K), 1024, 8, INF(9), (const float*)(ws + WS_COS), (const float*)(ws + WS_SIN), 1.0f, gw, NGW, lane, dry);
            norm_rows(nullptr, (const bf16*)(ws + WS_X), nullptr, INF(10), (bf16*)(ws + WS_H), nullptr, gw, NGW, lane);
            PH_END
        }
    }
#undef PH_BEGIN
#undef PH_END
}

#ifndef MK_PER_PHASE
#define MK_PER_PHASE 0
#endif
extern "C" void kernel_launch(void* const* d_in, const int* in_sizes, int n_in, void* d_out, int out_size, void* d_ws, size_t ws_size, hipStream_t stream) {
    static int grid = 0;
    if (grid == 0) {
        if (n_in != 22 || out_size != T * DM || ws_size < WS_END) { fprintf(stderr, "kernel_launch: unexpected problem (n_in %d, out %d, ws %zu)\n", n_in, out_size, ws_size); grid = -1; return; }
        int dev = 0, cus = 0, per_cu = 0;
        hipGetDevice(&dev); hipDeviceGetAttribute(&cus, hipDeviceAttributeMultiprocessorCount, dev);
        if (hipFuncSetAttribute((const void*)yoco_fwd, hipFuncAttributeMaxDynamicSharedMemorySize, LDS_BYTES) != hipSuccess) { fprintf(stderr, "kernel_launch: hipFuncSetAttribute failed\n"); grid = -1; return; }
        if (hipOccupancyMaxActiveBlocksPerMultiprocessor(&per_cu, (const void*)yoco_fwd, NTHR, LDS_BYTES) != hipSuccess || per_cu < 1) { fprintf(stderr, "kernel_launch: occupancy query says %d\n", per_cu); (void)hipGetLastError(); per_cu = 1; }
        grid = cus;
    }
    if (grid < 0) return;
    if (hipMemsetAsync(d_ws, 0, 16384, stream) != hipSuccess) { fprintf(stderr, "kernel_launch: memset failed\n"); return; }
    Args a{};
    for (int i = 0; i < 22; ++i) a.in[i] = d_in[i];
    a.out = (float*)d_out; a.ws = (unsigned char*)d_ws;
#if MK_PER_PHASE
    for (int p = 0; p < NPHASES; ++p) { a.ph_lo = p; a.ph_hi = p + 1; hipLaunchKernelGGL(yoco_fwd, dim3(grid), dim3(NTHR), LDS_BYTES, stream, a); }
#else
    a.ph_lo = 0; a.ph_hi = NPHASES;
    void* kargs[] = {&a};
    hipError_t e = hipLaunchCooperativeKernel((const void*)yoco_fwd, dim3(grid), dim3(NTHR), kargs, LDS_BYTES, stream);
    if (e != hipSuccess) fprintf(stderr, "kernel_launch: cooperative launch failed: %s (grid %d)\n", hipGetErrorString(e), grid);
#endif
}
```

```cpp
#include <hip/hip_runtime.h>
#include <hip/hip_cooperative_groups.h>
#include <cstdio>
#include <cstdint>
#include <cmath>
namespace pg8 {
#define PG8_LAS __attribute__((address_space(3)))
typedef unsigned short bf16_t;
typedef short bf16x8 __attribute__((ext_vector_type(8)));
typedef float f32x4 __attribute__((ext_vector_type(4)));
typedef unsigned u32x4 __attribute__((ext_vector_type(4)));
constexpr int BM = 256, BK = 64, HALF = 128, HTB = HALF * BK * 2  , STAGE_BYTES = 8 * HTB, NXCD = 8, WGM = 4;

__host__ __device__ __forceinline__ int lds_byte(int r, int c) { const int st = (r >> 4) * 2 + (c >> 5), rr = r & 15, cc = c & 31, ob = rr * 64 + cc * 2; return st * 1024 + (ob ^ (((ob >> 9) & 1) << 5)); }
__host__ __device__ __forceinline__ void stage_rc(int b, int& R, int& C) { const int st = b / 1024, sb = b % 1024, swz = sb ^ (((sb >> 9) & 1) << 5); R = (st >> 1) * 16 + swz / 64; C = (st & 1) * 32 + (swz % 64) / 2; }
__host__ __device__ __forceinline__ int perm32(int rho) { const int n = rho >> 4, i = rho & 15; return 8 * (i >> 2) + 4 * n + (i & 3); }

struct Unit { int pm, pn; };
struct Gemm { const bf16_t* A; const bf16_t* Bt; int M, N, K; };

struct StaticOrder {
    int nM, nN, nwg, G, c;
    __host__ __device__ void init(int M, int N, int G_, int c_) { nM = M / BM; nN = N / BM; nwg = nM * nN; G = G_; c = c_; }
    __host__ __device__ bool next(int i, Unit& u) const {
        const long L = (long)i * G + c; if (L >= nwg) return false;
        int wgid = (int)L; { const int q = nwg / NXCD, r = nwg % NXCD, xcd = wgid % NXCD, off = wgid / NXCD; wgid = (xcd < r ? xcd * (q + 1) : r * (q + 1) + (xcd - r) * q) + off; }
        const int nig = WGM * nN, gid = wgid / nig, fm = gid * WGM, gsz = (nM - fm) < WGM ? (nM - fm) : WGM;
        u.pm = fm + ((wgid % nig) % gsz); u.pn = (wgid % nig) / gsz; return true;
    }
    __device__ __forceinline__ void a_ready(const Unit&) const {}
    __device__ __forceinline__ void done(const Unit&) const {}
};

__device__ __forceinline__ unsigned cvt_pk_bf16(float lo, float hi) { unsigned r; asm volatile("v_cvt_pk_bf16_f32 %0, %1, %2" : "=v"(r) : "v"(lo), "v"(hi)); return r; }
typedef float f32x2 __attribute__((ext_vector_type(2)));
__device__ __forceinline__ f32x2 gelu_pk(f32x2 v) {
    const f32x2 av = __builtin_elementwise_abs(v), d = av * 0.2316418882f + 1.0f;
    f32x2 t; t.x = __builtin_amdgcn_rcpf(d.x); t.y = __builtin_amdgcn_rcpf(d.y);
    f32x2 q = t * 0.5307027145f + (-0.7265760135f); q = q * t + 0.7107068705f; q = q * t + (-0.142248368f); q = q * t + 0.127414796f; q = q * t;
    const f32x2 s = (v * v) * (-0.72134752044f);
    f32x2 e; e.x = __builtin_amdgcn_exp2f(s.x); e.y = __builtin_amdgcn_exp2f(s.y);
    const f32x2 m = v * (q * e), r = v - m;
    f32x2 o; o.x = v.x < 0.f ? m.x : r.x; o.y = v.y < 0.f ? m.y : r.y; return o;
}

template <int ACT  > struct EpiBf16 {
    static constexpr bool PERM = true, AFTER_DRAIN = false; static_assert(ACT == 0 || ACT == 1, "EpiBf16: ACT is 0 (none) or 1 (gelu_pk)");
    bf16_t* O; int ldc; const float* bias; int split_cols; size_t split_stride; float scale0;
    __device__ __forceinline__ void operator()(const f32x4 (&acc)[2][2][4][2], const Unit& u, int wr, int wc, int fr, int fq) const {
        const int row0 = u.pm * BM + wr * 64 + fr; int colt = u.pn * BM; bf16_t* base = O;
        float sc = 1.f; if (split_cols) { const int t = colt / split_cols; base += (size_t)t * split_stride; colt -= t * split_cols; if (t == 0) sc = scale0; }
        const int col0 = colt + wc * 32 + 8 * fq, bcol0 = u.pn * BM + wc * 32 + 8 * fq;
        f32x4 bv[2][2];
#pragma unroll
        for (int bj = 0; bj < 2; ++bj)
#pragma unroll
            for (int n = 0; n < 2; ++n) bv[bj][n] = bias ? *(const f32x4*)(bias + bcol0 + bj * HALF + 4 * n) : (f32x4){0.f, 0.f, 0.f, 0.f};
#pragma unroll
        for (int ai = 0; ai < 2; ++ai)
#pragma unroll
            for (int m = 0; m < 4; ++m) { bf16_t* rowp = base + (size_t)(row0 + ai * HALF + m * 16) * ldc + col0;
#pragma unroll
                for (int bj = 0; bj < 2; ++bj) { f32x4 v0 = acc[ai][bj][m][0] + bv[bj][0], v1 = acc[ai][bj][m][1] + bv[bj][1];
                    if (ACT == 1) { f32x2 a = gelu_pk((f32x2){v0[0], v0[1]}), b = gelu_pk((f32x2){v0[2], v0[3]}), c = gelu_pk((f32x2){v1[0], v1[1]}), d = gelu_pk((f32x2){v1[2], v1[3]});
                        v0 = (f32x4){a.x, a.y, b.x, b.y}; v1 = (f32x4){c.x, c.y, d.x, d.y}; }
                    v0 = v0 * sc; v1 = v1 * sc; u32x4 w; w.x = cvt_pk_bf16(v0[0], v0[1]); w.y = cvt_pk_bf16(v0[2], v0[3]); w.z = cvt_pk_bf16(v1[0], v1[1]); w.w = cvt_pk_bf16(v1[2], v1[3]);
                    *(u32x4*)(rowp + bj * HALF) = w; } }
    }
};
template <class Epi, class Sched, bool ALIGN_EPI = false, bool SP2 = false>
__device__ __forceinline__ void gemm_phase(PG8_LAS unsigned char* lds, const Gemm g, const Sched& S, const Epi& E) {
    int tid_l = threadIdx.x; asm volatile("" : "+v"(tid_l));
    const int tid = tid_l, wid = __builtin_amdgcn_readfirstlane(tid >> 6), lane = tid & 63, wr = wid >> 2, wc = wid & 3, fr = lane & 15, fq = lane >> 4;
    const int K = g.K, nt = K / BK;
    unsigned voffA[2], voffB[2];
#pragma unroll
    for (int i = 0; i < 2; ++i) { int R, C; stage_rc(tid * 16 + i * 8192, R, C); const int Rb = Epi::PERM ? ((R & ~31) + perm32(R & 31)) : R;
        voffA[i] = (unsigned)(R * K + C) * 2u; voffB[i] = (unsigned)(Rb * K + C) * 2u; }
    const size_t kstep = (size_t)(BK * 2);
    const size_t hstep = (size_t)HALF * K * 2;
    const size_t tstep = 2 * hstep;
    const unsigned ldsw = (unsigned)wid * 1024u;
    const int aoff = lds_byte(wr * 64 + fr, fq * 8), boff = lds_byte(wc * 32 + fr, fq * 8);
#define PG8_SA(b, h) (((b) * 2 + (h)) * HTB)
#define PG8_SB(b, h) ((4 + (b) * 2 + (h)) * HTB)
#define PG8_STAGE(bufoff, gbase, voff) do { _Pragma("unroll") for (int _i = 0; _i < 2; ++_i) \
        __builtin_amdgcn_global_load_lds((const unsigned*)((const char*)(gbase) + (voff)[_i]), (PG8_LAS unsigned*)(lds + (bufoff) + ldsw + _i * 8192), 16, 0, 0); } while (0)
#define PG8_LDA(dst, b, h) do { _Pragma("unroll") for (int m = 0; m < 4; ++m) _Pragma("unroll") for (int k = 0; k < 2; ++k) dst[m][k] = *(const PG8_LAS bf16x8*)(lds + PG8_SA(b, h) + aoff + m * 2048 + k * 1024); } while (0)
#define PG8_LDB(dst, b, h) do { _Pragma("unroll") for (int n = 0; n < 2; ++n) _Pragma("unroll") for (int k = 0; k < 2; ++k) dst[n][k] = *(const PG8_LAS bf16x8*)(lds + PG8_SB(b, h) + boff + n * 2048 + k * 1024); } while (0)
#define PG8_MMA(ai, bj, At, Bt) do { __builtin_amdgcn_s_setprio(1); _Pragma("unroll") for (int m = 0; m < 4; ++m) _Pragma("unroll") for (int n = 0; n < 2; ++n) _Pragma("unroll") for (int k = 0; k < 2; ++k) \
        acc[ai][bj][m][n] = __builtin_amdgcn_mfma_f32_16x16x32_bf16(Bt[n][k], At[m][k], acc[ai][bj][m][n], 0, 0, 0); __builtin_amdgcn_s_setprio(0); } while (0)
#define PG8_WAIT_V(n) asm volatile("s_waitcnt vmcnt(" #n ")" ::: "memory")
#define PG8_WAIT_L(n) asm volatile("s_waitcnt lgkmcnt(" #n ")" ::: "memory")
#define PG8_BAR __builtin_amdgcn_s_barrier()
#define PG8_SCHED __builtin_amdgcn_sched_barrier(0)
    Unit cur, nxt; int ui = 0;
    if (!S.next(0, cur)) return;
    f32x4 acc[2][2][4][2];
#pragma unroll
    for (int a = 0; a < 2; ++a)
#pragma unroll
        for (int b = 0; b < 2; ++b)
#pragma unroll
            for (int m = 0; m < 4; ++m)
#pragma unroll
                for (int n = 0; n < 2; ++n) acc[a][b][m][n] = (f32x4){0.f, 0.f, 0.f, 0.f};
    bf16x8 At[4][2], B0[2][2], B1[2][2];
    const char* cA = (const char*)g.A + (size_t)cur.pm * tstep; const char* cB = (const char*)g.Bt + (size_t)cur.pn * tstep;
    S.a_ready(cur);
    if constexpr (SP2) {
        PG8_STAGE(PG8_SB(0, 0), cB, voffB); PG8_STAGE(PG8_SB(0, 1), cB + hstep, voffB); PG8_STAGE(PG8_SA(0, 0), cA, voffA); PG8_STAGE(PG8_SA(0, 1), cA + hstep, voffA);
        if (wr == 1) PG8_BAR;
        PG8_WAIT_V(2); PG8_BAR;
        PG8_STAGE(PG8_SB(1, 0), cB + kstep, voffB); PG8_STAGE(PG8_SA(1, 0), cA + kstep, voffA); PG8_STAGE(PG8_SB(1, 1), cB + hstep + kstep, voffB);
        PG8_WAIT_V(6); PG8_BAR;
    } else {
        PG8_STAGE(PG8_SB(0, 0), cB, voffB); PG8_STAGE(PG8_SA(0, 0), cA, voffA); PG8_STAGE(PG8_SB(0, 1), cB + hstep, voffB); PG8_STAGE(PG8_SA(0, 1), cA + hstep, voffA);
        if (wr == 1) PG8_BAR;
        PG8_WAIT_V(4); PG8_BAR;
        PG8_STAGE(PG8_SB(1, 0), cB + kstep, voffB); PG8_STAGE(PG8_SA(1, 0), cA + kstep, voffA); PG8_STAGE(PG8_SB(1, 1), cB + hstep + kstep, voffB);
        PG8_WAIT_V(6); PG8_BAR;
    }
    for (;;) {
        const bool has_next = S.next(ui + 1, nxt);
        const char* nA = has_next ? (const char*)g.A + (size_t)nxt.pm * tstep : cA; const char* nB = has_next ? (const char*)g.Bt + (size_t)nxt.pn * tstep : cB;
        for (int t = 0; t < nt; t += 2) {
            const bool last = (t == nt - 2);
            const char* a1 = cA + (size_t)(t + 1) * kstep;
            const char* a2 = last ? nA : cA + (size_t)(t + 2) * kstep; const char* b2 = last ? nB : cB + (size_t)(t + 2) * kstep;
            const char* a3 = a2 + kstep; const char* b3 = b2 + kstep;
            if (last && has_next) S.a_ready(nxt);
            if constexpr (SP2) {
            PG8_LDB(B0, 0, 0); PG8_LDB(B1, 0, 1); PG8_SCHED; PG8_LDA(At, 0, 0); PG8_STAGE(PG8_SA(1, 1), a1 + hstep, voffA);
            PG8_WAIT_V(8); PG8_WAIT_L(0); PG8_BAR; PG8_MMA(0, 0, At, B0); PG8_MMA(0, 1, At, B1); PG8_BAR; PG8_SCHED;
            PG8_LDA(At, 0, 1); PG8_STAGE(PG8_SB(0, 0), b2, voffB); PG8_STAGE(PG8_SB(0, 1), b2 + hstep, voffB); PG8_STAGE(PG8_SA(0, 0), a2, voffA);
            PG8_WAIT_V(8); PG8_WAIT_L(0); PG8_BAR; PG8_MMA(1, 0, At, B0); PG8_MMA(1, 1, At, B1); PG8_BAR; PG8_SCHED;
            PG8_LDB(B0, 1, 0); PG8_LDB(B1, 1, 1); PG8_SCHED; PG8_LDA(At, 1, 0); PG8_STAGE(PG8_SA(0, 1), a2 + hstep, voffA);
            PG8_WAIT_V(8); PG8_WAIT_L(0); PG8_BAR; PG8_MMA(0, 0, At, B0); PG8_MMA(0, 1, At, B1); PG8_BAR; PG8_SCHED;
            PG8_LDA(At, 1, 1); PG8_STAGE(PG8_SB(1, 0), b3, voffB); PG8_STAGE(PG8_SB(1, 1), b3 + hstep, voffB); PG8_STAGE(PG8_SA(1, 0), a3, voffA);
            PG8_WAIT_V(8); PG8_WAIT_L(0); PG8_BAR; PG8_MMA(1, 0, At, B0); PG8_MMA(1, 1, At, B1); PG8_BAR; PG8_SCHED;
            } else {
            PG8_LDB(B0, 0, 0); PG8_SCHED; PG8_LDA(At, 0, 0); PG8_STAGE(PG8_SA(1, 1), a1 + hstep, voffA);
            PG8_WAIT_L(8); PG8_BAR; PG8_WAIT_L(0); PG8_MMA(0, 0, At, B0); PG8_BAR; PG8_SCHED;
            PG8_LDB(B1, 0, 1); PG8_STAGE(PG8_SB(0, 0), b2, voffB);
            PG8_BAR; PG8_WAIT_L(0); PG8_MMA(0, 1, At, B1); PG8_BAR;
            PG8_LDA(At, 0, 1); PG8_STAGE(PG8_SA(0, 0), a2, voffA);
            PG8_BAR; PG8_WAIT_L(0); PG8_MMA(1, 0, At, B0); PG8_BAR; PG8_SCHED;
            PG8_STAGE(PG8_SB(0, 1), b2 + hstep, voffB);
            PG8_WAIT_V(6); PG8_BAR; PG8_MMA(1, 1, At, B1); PG8_BAR;
            PG8_LDB(B0, 1, 0); PG8_SCHED; PG8_LDA(At, 1, 0); PG8_STAGE(PG8_SA(0, 1), a2 + hstep, voffA);
            PG8_WAIT_L(8); PG8_BAR; PG8_WAIT_L(0); PG8_MMA(0, 0, At, B0); PG8_BAR; PG8_SCHED;
            PG8_LDB(B1, 1, 1); PG8_STAGE(PG8_SB(1, 0), b3, voffB);
            PG8_BAR; PG8_WAIT_L(0); PG8_MMA(0, 1, At, B1); PG8_BAR;
            PG8_LDA(At, 1, 1); PG8_STAGE(PG8_SA(1, 0), a3, voffA);
            PG8_BAR; PG8_WAIT_L(0); PG8_MMA(1, 0, At, B0); PG8_BAR; PG8_SCHED;
            PG8_STAGE(PG8_SB(1, 1), b3 + hstep, voffB);
            PG8_WAIT_V(6); PG8_BAR; PG8_MMA(1, 1, At, B1); PG8_BAR;
            }
        }
        if constexpr (ALIGN_EPI) { if (wr == 0) PG8_BAR; }
        if constexpr (!Epi::AFTER_DRAIN) { E(acc, cur, wr, wc, fr, fq); S.done(cur); }
        if (!has_next) break;
#pragma unroll
        for (int a = 0; a < 2; ++a)
#pragma unroll
            for (int b = 0; b < 2; ++b)
#pragma unroll
                for (int m = 0; m < 4; ++m)
#pragma unroll
                    for (int n = 0; n < 2; ++n) acc[a][b][m][n] = (f32x4){0.f, 0.f, 0.f, 0.f};
        cur = nxt; cA = nA; cB = nB; ++ui;
        if constexpr (ALIGN_EPI) { if (wr == 1) PG8_BAR; }
    }
    PG8_WAIT_V(0);
    if constexpr (!ALIGN_EPI) { if (wr == 0) PG8_BAR; }
    PG8_BAR;
    if constexpr (Epi::AFTER_DRAIN) { E.fused(acc, cur, wr, wc, fr, fq, lds, wid, lane); S.done(cur); }
#undef PG8_SA
#undef PG8_SB
#undef PG8_STAGE
#undef PG8_LDA
#undef PG8_LDB
#undef PG8_MMA
#undef PG8_WAIT_V
#undef PG8_WAIT_L
#undef PG8_BAR
#undef PG8_SCHED
}
}
#ifndef PROBE_ABL
#define PROBE_ABL 0
#endif

namespace pg8 {
struct EpiWin {
    static constexpr bool PERM = true, AFTER_DRAIN = false;
    bf16_t* Bo; bf16_t* CU;
    __device__ __forceinline__ void operator()(const f32x4 (&acc)[2][2][4][2], const Unit& u, int wr, int wc, int fr, int fq) const {
        const int row0 = u.pm * BM + wr * 64 + fr;
        if (u.pn < 4) {
            const int col0 = u.pn * BM + wc * 32 + 8 * fq;
#pragma unroll
            for (int ai = 0; ai < 2; ++ai)
#pragma unroll
                for (int m = 0; m < 4; ++m) { bf16_t* rowp = Bo + (size_t)(row0 + ai * HALF + m * 16) * 1024 + col0;
#pragma unroll
                    for (int bj = 0; bj < 2; ++bj) { const f32x4 v0 = acc[ai][bj][m][0], v1 = acc[ai][bj][m][1];
                        u32x4 w; w.x = cvt_pk_bf16(v0[0], v0[1]); w.y = cvt_pk_bf16(v0[2], v0[3]); w.z = cvt_pk_bf16(v1[0], v1[1]); w.w = cvt_pk_bf16(v1[2], v1[3]);
                        *(u32x4*)(rowp + bj * HALF) = w; } }
        } else {
            const int col0 = (u.pn - 4) * HALF + wc * 32 + 8 * fq;
#pragma unroll
            for (int ai = 0; ai < 2; ++ai)
#pragma unroll
                for (int m = 0; m < 4; ++m) { bf16_t* rowp = CU + (size_t)(row0 + ai * HALF + m * 16) * 1024 + col0;
                    const f32x4 v0 = acc[ai][0][m][0] * acc[ai][1][m][0], v1 = acc[ai][0][m][1] * acc[ai][1][m][1];
                    u32x4 w; w.x = cvt_pk_bf16(v0[0], v0[1]); w.y = cvt_pk_bf16(v0[2], v0[3]); w.z = cvt_pk_bf16(v1[0], v1[1]); w.w = cvt_pk_bf16(v1[2], v1[3]);
                    *(u32x4*)rowp = w; }
        }
    }
};
struct EpiF32 {
    static constexpr bool PERM = false, AFTER_DRAIN = false;
    const float* res; float* out; int ldc;
    __device__ __forceinline__ void operator()(const f32x4 (&acc)[2][2][4][2], const Unit& u, int wr, int wc, int fr, int fq) const {
        const int row0 = u.pm * BM + wr * 64 + fr, col0 = u.pn * BM + wc * 32 + 4 * fq;
#pragma unroll
        for (int ai = 0; ai < 2; ++ai)
#pragma unroll
            for (int m = 0; m < 4; ++m) { const size_t off = (size_t)(row0 + ai * HALF + m * 16) * ldc + col0;
#pragma unroll
                for (int bj = 0; bj < 2; ++bj)
#pragma unroll
                    for (int n = 0; n < 2; ++n) { const size_t p = off + bj * HALF + n * 16; f32x4 v = acc[ai][bj][m][n];
                        if (res) v += *(const f32x4*)(res + p);
                        *(f32x4*)(out + p) = v; } }
    }
};
__device__ __forceinline__ void unpack8(const u32x4& w, f32x4& lo, f32x4& hi) {
    lo[0] = __uint_as_float(w.x << 16); lo[1] = __uint_as_float(w.x & 0xffff0000u); lo[2] = __uint_as_float(w.y << 16); lo[3] = __uint_as_float(w.y & 0xffff0000u);
    hi[0] = __uint_as_float(w.z << 16); hi[1] = __uint_as_float(w.z & 0xffff0000u); hi[2] = __uint_as_float(w.w << 16); hi[3] = __uint_as_float(w.w & 0xffff0000u);
}
struct EpiResB {
    static constexpr bool PERM = true, AFTER_DRAIN = false;
    const bf16_t* xin; bf16_t* xout;
    __device__ __forceinline__ void operator()(const f32x4 (&acc)[2][2][4][2], const Unit& u, int wr, int wc, int fr, int fq) const {
        const int row0 = u.pm * BM + wr * 64 + fr, col0 = u.pn * BM + wc * 32 + 8 * fq;
        u32x4 xr[2][4][2];
#pragma unroll
        for (int ai = 0; ai < 2; ++ai)
#pragma unroll
            for (int m = 0; m < 4; ++m)
#pragma unroll
                for (int bj = 0; bj < 2; ++bj) xr[ai][m][bj] = *(const u32x4*)(xin + (size_t)(row0 + ai * HALF + m * 16) * 1024 + col0 + bj * HALF);
#pragma unroll
        for (int ai = 0; ai < 2; ++ai)
#pragma unroll
            for (int m = 0; m < 4; ++m) { const size_t off = (size_t)(row0 + ai * HALF + m * 16) * 1024 + col0;
#pragma unroll
                for (int bj = 0; bj < 2; ++bj) { const size_t p = off + bj * HALF; f32x4 lo, hi; unpack8(xr[ai][m][bj], lo, hi);
                    lo += acc[ai][bj][m][0]; hi += acc[ai][bj][m][1];
                    u32x4 w; w.x = cvt_pk_bf16(lo[0], lo[1]); w.y = cvt_pk_bf16(lo[2], lo[3]); w.z = cvt_pk_bf16(hi[0], hi[1]); w.w = cvt_pk_bf16(hi[2], hi[3]);
                    *(u32x4*)(xout + p) = w; } }
    }
};
struct EpiPleB {
    static constexpr bool PERM = true, AFTER_DRAIN = false;
    const bf16_t* xin; bf16_t* xout; const bf16_t* P; float* outf;
    __device__ __forceinline__ void operator()(const f32x4 (&acc)[2][2][4][2], const Unit& u, int wr, int wc, int fr, int fq) const {
        const int row0 = u.pm * BM + wr * 64 + fr, col0 = u.pn * BM + wc * 32 + 8 * fq;
#pragma unroll
        for (int ai = 0; ai < 2; ++ai) {
            u32x4 xr[4][2], pr[4][2];
#pragma unroll
            for (int m = 0; m < 4; ++m)
#pragma unroll
                for (int bj = 0; bj < 2; ++bj) { const size_t p = (size_t)(row0 + ai * HALF + m * 16) * 1024 + col0 + bj * HALF; xr[m][bj] = *(const u32x4*)(xin + p); pr[m][bj] = *(const u32x4*)(P + p); }
#pragma unroll
            for (int m = 0; m < 4; ++m) { const size_t off = (size_t)(row0 + ai * HALF + m * 16) * 1024 + col0;
#pragma unroll
                for (int bj = 0; bj < 2; ++bj) { const size_t p = off + bj * HALF; f32x4 lo, hi, pl, ph; unpack8(xr[m][bj], lo, hi); unpack8(pr[m][bj], pl, ph);
                    const f32x4 a0 = acc[ai][bj][m][0], a1 = acc[ai][bj][m][1];
#pragma unroll
                    for (int e = 0; e < 4; ++e) { lo[e] += pl[e] * __builtin_amdgcn_rcpf(1.0f + __builtin_amdgcn_exp2f(-1.4426950408889634f * a0[e])); hi[e] += ph[e] * __builtin_amdgcn_rcpf(1.0f + __builtin_amdgcn_exp2f(-1.4426950408889634f * a1[e])); }
                    if (outf) { *(f32x4*)(outf + p) = lo; *(f32x4*)(outf + p + 4) = hi; }
                    else { u32x4 w; w.x = cvt_pk_bf16(lo[0], lo[1]); w.y = cvt_pk_bf16(lo[2], lo[3]); w.z = cvt_pk_bf16(hi[0], hi[1]); w.w = cvt_pk_bf16(hi[2], hi[3]);
                        *(u32x4*)(xout + p) = w; } } } }
    }
};
}

namespace cg = cooperative_groups;
#define LAS __attribute__((address_space(3)))
typedef unsigned short bf16;
typedef unsigned u32x4 __attribute__((ext_vector_type(4)));
typedef unsigned u32x2 __attribute__((ext_vector_type(2)));
typedef float f32x4 __attribute__((ext_vector_type(4)));
typedef float f32x2 __attribute__((ext_vector_type(2)));
typedef short bf16x8 __attribute__((ext_vector_type(8)));
typedef short s16x4 __attribute__((ext_vector_type(4)));
typedef __bf16 bf16x2_t __attribute__((ext_vector_type(2)));

constexpr int BATCH = 16, SEQ = 2048, DM = 1024, T = BATCH * SEQ, DEPTH = 4;
constexpr float EPS = 1e-6f;
constexpr int NTHR = 512, NWV = 8;
constexpr int LDS_BYTES = 147456;
constexpr int NPHASES = 48;

constexpr size_t MiB = 1u << 20;
constexpr size_t WS_WIN = 2 * MiB, WS_WOUT = 14 * MiB, WS_WKV = 18 * MiB, WS_WQ = 22 * MiB, WS_WO = 34 * MiB, WS_WPQ = 38 * MiB, WS_WGATE = 54 * MiB, WS_WPROJ = 62 * MiB;
constexpr size_t WS_COS = 64 * MiB, WS_SIN = 66 * MiB, WS_IDX = 68 * MiB, WS_GATE = 84 * MiB, WS_H = 100 * MiB, WS_K = 164 * MiB, WS_V = 228 * MiB;
constexpr size_t WS_PB = 292 * MiB, WS_PBF = 356 * MiB, WS_BIG = 420 * MiB, WS_UBF = 676 * MiB, WS_VBF = 804 * MiB, WS_X = 932 * MiB, WS_END = 996 * MiB;

#define LDS_WAIT() asm volatile("s_waitcnt lgkmcnt(0)" ::: "memory")

__device__ __forceinline__ unsigned pk2(float lo, float hi) { f32x2 v = {lo, hi}; bf16x2_t b = __builtin_convertvector(v, bf16x2_t); return __builtin_bit_cast(unsigned, b); }
__device__ __forceinline__ float bflo(unsigned w) { return __uint_as_float(w << 16); }
__device__ __forceinline__ float bfhi(unsigned w) { return __uint_as_float(w & 0xffff0000u); }
__device__ __forceinline__ float dot2(unsigned a, unsigned b, float c) { return __builtin_amdgcn_fdot2_f32_bf16(__builtin_bit_cast(bf16x2_t, a), __builtin_bit_cast(bf16x2_t, b), c, false); }
__device__ __forceinline__ float wsum(float v) {
#pragma unroll
    for (int o = 1; o < 64; o <<= 1) v += __shfl_xor(v, o);
    return v;
}
__device__ __forceinline__ float wmaxf(float v) {
#pragma unroll
    for (int o = 1; o < 64; o <<= 1) v = fmaxf(v, __shfl_xor(v, o));
    return v;
}
__device__ __forceinline__ float gelu_erf(float x) { return 0.5f * x * (1.0f + erff(x * 0.70710678118654752f)); }

__device__ __forceinline__ int win_map(int n) { if (n < 1024) return n; const int ch = (n - 1024) & 1023, isu = (n >= 2048) ? 1 : 0; return 1024 + (ch >> 7) * 256 + isu * 128 + (ch & 127); }
__device__ __forceinline__ void transpose_item(const float* W, int K, int N, bf16* WT, int mode, LAS float* scr, int item, int lane) {
    const int nblk = N / 32, kb = item / nblk, nb = item % nblk, k0 = 64 * kb, n0 = 32 * nb;
#pragma unroll
    for (int i = 0; i < 8; ++i) { const int kk = 8 * i + (lane >> 3); const f32x4 v = *(const f32x4*)(W + (size_t)(k0 + kk) * N + n0 + 4 * (lane & 7));
        LAS float* d = scr + kk * 33 + 4 * (lane & 7); d[0] = v[0]; d[1] = v[1]; d[2] = v[2]; d[3] = v[3]; }
    LDS_WAIT();
    const int d0 = mode ? win_map(n0) : n0;
    const int c = lane & 7;
#pragma unroll
    for (int j = 0; j < 4; ++j) { const int n = (lane >> 3) + 8 * j; const LAS float* s = scr + (8 * c) * 33 + n;
        u32x4 o; o.x = pk2(s[0 * 33], s[1 * 33]); o.y = pk2(s[2 * 33], s[3 * 33]); o.z = pk2(s[4 * 33], s[5 * 33]); o.w = pk2(s[6 * 33], s[7 * 33]);
        *(u32x4*)(WT + (size_t)(d0 + n) * K + k0 + 8 * c) = o; }
    LDS_WAIT();
}
__device__ __forceinline__ void cvt_bulk(const float* src, bf16* dst, size_t n8, size_t gtid, size_t nthr) {
    for (size_t i = gtid; i < n8; i += nthr) { const f32x4 a = ((const f32x4*)src)[2 * i], b = ((const f32x4*)src)[2 * i + 1];
        u32x4 o; o.x = pk2(a[0], a[1]); o.y = pk2(a[2], a[3]); o.z = pk2(b[0], b[1]); o.w = pk2(b[2], b[3]); ((u32x4*)dst)[i] = o; }
}
template <int RB> __device__ __forceinline__ void norm_rows_blk(const float* Xf, const bf16* Xb, const bf16* Yadd, const f32x4 (&gv)[4], bf16* H, bf16* Xout, int r0, int NGW, int lane) {
    f32x4 v[RB][4]; float s[RB];
#pragma unroll
    for (int u = 0; u < RB; ++u)
#pragma unroll
        for (int j = 0; j < 2; ++j) { const size_t p = (size_t)(r0 + u * NGW) * DM + 512 * j + 8 * lane;
            if (Xf) { v[u][2 * j] = *(const f32x4*)(Xf + p); v[u][2 * j + 1] = *(const f32x4*)(Xf + p + 4); }
            else { const u32x4 w = *(const u32x4*)(Xb + p); v[u][2 * j] = (f32x4){bflo(w.x), bfhi(w.x), bflo(w.y), bfhi(w.y)}; v[u][2 * j + 1] = (f32x4){bflo(w.z), bfhi(w.z), bflo(w.w), bfhi(w.w)}; }
            if (Yadd) { const u32x4 w = *(const u32x4*)(Yadd + p); v[u][2 * j] += (f32x4){bflo(w.x), bfhi(w.x), bflo(w.y), bfhi(w.y)}; v[u][2 * j + 1] += (f32x4){bflo(w.z), bfhi(w.z), bflo(w.w), bfhi(w.w)}; } }
#pragma unroll
    for (int u = 0; u < RB; ++u) { float t = 0.f;
#pragma unroll
        for (int j = 0; j < 4; ++j) t += (v[u][j][0] * v[u][j][0] + v[u][j][1] * v[u][j][1]) + (v[u][j][2] * v[u][j][2] + v[u][j][3] * v[u][j][3]);
        s[u] = t; }
#pragma unroll
    for (int u = 0; u < RB; ++u) s[u] = wsum(s[u]);
#pragma unroll
    for (int u = 0; u < RB; ++u) {
        const float rstd = 1.0f / sqrtf(s[u] * (1.0f / DM) + EPS);
#pragma unroll
        for (int j = 0; j < 2; ++j) { const size_t p = (size_t)(r0 + u * NGW) * DM + 512 * j + 8 * lane; const f32x4 a = v[u][2 * j], b = v[u][2 * j + 1];
            if (Xout) { u32x4 w; w.x = pk2(a[0], a[1]); w.y = pk2(a[2], a[3]); w.z = pk2(b[0], b[1]); w.w = pk2(b[2], b[3]); *(u32x4*)(Xout + p) = w; }
            const f32x4 ga = gv[2 * j], gb = gv[2 * j + 1];
            u32x4 h; h.x = pk2(a[0] * rstd * ga[0], a[1] * rstd * ga[1]); h.y = pk2(a[2] * rstd * ga[2], a[3] * rstd * ga[3]);
            h.z = pk2(b[0] * rstd * gb[0], b[1] * rstd * gb[1]); h.w = pk2(b[2] * rstd * gb[2], b[3] * rstd * gb[3]);
            *(u32x4*)(H + p) = h; }
    }
}
__device__ __forceinline__ void norm_rows(const float* Xf, const bf16* Xb, const bf16* Yadd, const float* gain, bf16* H, bf16* Xout, int r0, int NGW, int rend, int lane) {
    f32x4 gv[4];
#pragma unroll
    for (int j = 0; j < 2; ++j) { gv[2 * j] = *(const f32x4*)(gain + 512 * j + 8 * lane); gv[2 * j + 1] = *(const f32x4*)(gain + 512 * j + 8 * lane + 4); }
    int r = r0;
    if (!Xf) for (; r + 7 * NGW < rend; r += 8 * NGW) norm_rows_blk<8>(Xf, Xb, Yadd, gv, H, Xout, r, NGW, lane);
    for (; r + 3 * NGW < rend; r += 4 * NGW) norm_rows_blk<4>(Xf, Xb, Yadd, gv, H, Xout, r, NGW, lane);
    for (; r < rend; r += NGW) norm_rows_blk<1>(Xf, Xb, Yadd, gv, H, Xout, r, NGW, lane);
}
__device__ __forceinline__ void split_bf16(const f32x4& a, const f32x4& b, u32x4& h, u32x4& l) {
    h.x = pk2(a[0], a[1]); h.y = pk2(a[2], a[3]); h.z = pk2(b[0], b[1]); h.w = pk2(b[2], b[3]);
    l.x = pk2(a[0] - bflo(h.x), a[1] - bfhi(h.x)); l.y = pk2(a[2] - bflo(h.y), a[3] - bfhi(h.y)); l.z = pk2(b[0] - bflo(h.z), b[1] - bfhi(h.z)); l.w = pk2(b[2] - bflo(h.w), b[3] - bfhi(h.w));
}
__device__ __forceinline__ void precombine_item(const float* WQ, const float* SK, bf16* WPQ, LAS unsigned char* lds, int item, int tid, int wave, int lane) {
    const int layer = item >> 6, hp = (item >> 2) & 15, quarter = item & 3;
    const float* skg = SK + (size_t)(layer * 16 + hp) * 128 * 128;
    constexpr int SROW = 272;
    LAS unsigned char* Shi = lds; LAS unsigned char* Slo = lds + 128 * SROW;
    const int li = lane & 15, G = lane >> 4, kb = quarter * 256 + 32 * wave;
    __syncthreads();
    { const int row = tid >> 2, c0 = (tid & 3) * 32;
      f32x4 v[8];
#pragma unroll
      for (int q = 0; q < 8; ++q) v[q] = *(const f32x4*)(skg + row * 128 + c0 + 4 * q);
#pragma unroll
      for (int q = 0; q < 4; ++q) { u32x4 h, l; split_bf16(v[2 * q], v[2 * q + 1], h, l);
          *(LAS u32x4*)(Shi + row * SROW + (c0 + 8 * q) * 2) = h; *(LAS u32x4*)(Slo + row * SROW + (c0 + 8 * q) * 2) = l; } }
    u32x4 xh[2][4], xl[2][4];
#pragma unroll
    for (int kt = 0; kt < 2; ++kt)
#pragma unroll
        for (int cs = 0; cs < 4; ++cs) { const float* p = WQ + ((size_t)layer * 1024 + kb + kt * 16 + li) * 2048 + hp * 128 + cs * 32 + 8 * G;
            split_bf16(*(const f32x4*)p, *(const f32x4*)(p + 4), xh[kt][cs], xl[kt][cs]); }
    __syncthreads();
#pragma unroll
    for (int mt = 0; mt < 8; ++mt) {
        f32x4 acc[2] = {{0.f, 0.f, 0.f, 0.f}, {0.f, 0.f, 0.f, 0.f}};
#pragma unroll
        for (int cs = 0; cs < 4; ++cs) {
            const u32x4 yh4 = *(const LAS u32x4*)(Shi + (mt * 16 + li) * SROW + (cs * 32 + 8 * G) * 2), yl4 = *(const LAS u32x4*)(Slo + (mt * 16 + li) * SROW + (cs * 32 + 8 * G) * 2);
            const bf16x8 yh = __builtin_bit_cast(bf16x8, yh4), yl = __builtin_bit_cast(bf16x8, yl4);
#pragma unroll
            for (int kt = 0; kt < 2; ++kt) { const bf16x8 ah = __builtin_bit_cast(bf16x8, xh[kt][cs]), al = __builtin_bit_cast(bf16x8, xl[kt][cs]);
                acc[kt] = __builtin_amdgcn_mfma_f32_16x16x32_bf16(ah, yh, acc[kt], 0, 0, 0);
                acc[kt] = __builtin_amdgcn_mfma_f32_16x16x32_bf16(ah, yl, acc[kt], 0, 0, 0);
                acc[kt] = __builtin_amdgcn_mfma_f32_16x16x32_bf16(al, yh, acc[kt], 0, 0, 0); } }
#pragma unroll
        for (int kt = 0; kt < 2; ++kt) { u32x2 o; o.x = pk2(acc[kt][0], acc[kt][1]); o.y = pk2(acc[kt][2], acc[kt][3]);
            *(u32x2*)(WPQ + ((size_t)layer * 2048 + hp * 128 + mt * 16 + li) * 1024 + kb + kt * 16 + 4 * G) = o; }
    }
}

__device__ __forceinline__ void conv_gate(const bf16* Bg, const bf16* CU, const float* CW, bf16* Gout, size_t i0, size_t nthr, size_t iend) {
    for (size_t i = i0; i < iend; i += nthr) {
        const int t = (int)(i >> 7), c8 = (int)(i & 127) * 8, s = t & (SEQ - 1);
        const size_t off = (size_t)t * DM + c8;
        const u32x4 bb = *(const u32x4*)(Bg + off), c0 = *(const u32x4*)(CU + off);
        u32x4 c1 = {0u, 0u, 0u, 0u}, c2 = {0u, 0u, 0u, 0u};
        if (s >= 1) c1 = *(const u32x4*)(CU + off - DM);
        if (s >= 2) c2 = *(const u32x4*)(CU + off - 2 * DM);
        float k0[8], k1[8], k2[8];
#pragma unroll
        for (int e = 0; e < 8; ++e) { k0[e] = CW[c8 + e]; k1[e] = CW[DM + c8 + e]; k2[e] = CW[2 * DM + c8 + e]; }
        unsigned ow[4];
#pragma unroll
        for (int q = 0; q < 4; ++q) {
            const float zl = k0[2 * q] * bflo(c2[q]) + k1[2 * q] * bflo(c1[q]) + k2[2 * q] * bflo(c0[q]);
            const float zh = k0[2 * q + 1] * bfhi(c2[q]) + k1[2 * q + 1] * bfhi(c1[q]) + k2[2 * q + 1] * bfhi(c0[q]);
            ow[q] = pk2(bflo(bb[q]) * zl, bfhi(bb[q]) * zh);
        }
        u32x4 o = {ow[0], ow[1], ow[2], ow[3]};
        *(u32x4*)(Gout + off) = o;
    }
}

__device__ __forceinline__ int f2s(float f) { const int b = __float_as_int(f); return b ^ ((b >> 31) & 0x7fffffff); }
__device__ __forceinline__ float s2f(int s) { return __int_as_float(s ^ ((s >> 31) & 0x7fffffff)); }
__device__ __forceinline__ void ins16(int (&l)[16], int x) {
#pragma unroll
    for (int i = 0; i < 16; ++i) { const int t = max(l[i], x); x = min(l[i], x); l[i] = t; }
}
__device__ __forceinline__ unsigned sel4(unsigned w0, unsigned w1, unsigned w2, unsigned w3, int i) { return (i & 2) ? ((i & 1) ? w3 : w2) : ((i & 1) ? w1 : w0); }
__device__ __forceinline__ void merge16(int (&o)[16], const int (&A)[16], const int (&B)[16]) {
#pragma unroll
    for (int i = 0; i < 16; ++i) o[i] = max(A[i], B[15 - i]);
#pragma unroll
    for (int st = 8; st >= 1; st >>= 1)
#pragma unroll
        for (int i = 0; i < 16; ++i) if ((i & st) == 0) { const int hi = max(o[i], o[i + st]), lo = min(o[i], o[i + st]); o[i] = hi; o[i + st] = lo; }
}
__device__ __forceinline__ void sort16_desc(int (&x)[16]) {
#pragma unroll
    for (int k = 2; k <= 16; k <<= 1)
#pragma unroll
        for (int j = k >> 1; j > 0; j >>= 1)
#pragma unroll
            for (int i = 0; i < 16; ++i) { const int l = i ^ j;
                if (l > i) { const int hi = max(x[i], x[l]), lo = min(x[i], x[l]); const bool desc = ((i & k) == 0) || (k == 16);
                    x[i] = desc ? hi : lo; x[l] = desc ? lo : hi; } }
}
__device__ __forceinline__ void topk_job(const bf16* base, size_t rstride, size_t item0, size_t istride, unsigned short* IDX, float* GATE, LAS unsigned char* wl, int lane) {
    {
        const bf16* gsrc = base + (size_t)(lane >> 3) * rstride + (lane & 7) * 8;
        int l1[16], l2[16];
#pragma unroll
        for (int i = 0; i < 16; ++i) { l1[i] = (int)0x80000000; l2[i] = (int)0x80000000; }
        u32x4 nx[8];
#pragma unroll
        for (int k = 0; k < 8; ++k) nx[k] = *(const u32x4*)(gsrc + (size_t)k * 8 * rstride);
#pragma unroll
        for (int p = 0; p < 2; ++p) {
#pragma unroll
            for (int cc = 0; cc < 2; ++cc) {
#pragma unroll
                for (int k = 0; k < 8; ++k) *(LAS u32x4*)(wl + ((lane >> 3) + 8 * k) * 144 + (lane & 7) * 16) = nx[k];
                const int cn = p * 2 + cc + 1;
                if (cn < 4) {
#pragma unroll
                    for (int k = 0; k < 8; ++k) nx[k] = *(const u32x4*)(gsrc + (size_t)k * 8 * rstride + cn * 64);
                }
                u32x4 v[8];
#pragma unroll
                for (int m = 0; m < 8; ++m) v[m] = *(const LAS u32x4*)(wl + lane * 144 + 16 * m);
                int kk[4][16], ta[16], tb[16];
#pragma unroll
                for (int j = 0; j < 64; ++j) { const unsigned w = v[j >> 3][(j >> 1) & 3]; const int bits = (int)((j & 1) ? (w & 0xffff0000u) : (w << 16));
                    kk[j >> 4][j & 15] = ((bits ^ ((bits >> 31) & 0x7fffffff)) & ~127) | (cc * 64 + j); }
                sort16_desc(kk[0]); sort16_desc(kk[1]); sort16_desc(kk[2]); sort16_desc(kk[3]);
                if (p == 0) { merge16(ta, l1, kk[0]); merge16(tb, ta, kk[1]); merge16(ta, tb, kk[2]); merge16(l1, ta, kk[3]); }
                else        { merge16(ta, l2, kk[0]); merge16(tb, ta, kk[1]); merge16(ta, tb, kk[2]); merge16(l2, ta, kk[3]); }
            }
        }
        float s1f[16], s2v[16];
#pragma unroll
        for (int i = 0; i < 16; ++i) { s1f[i] = s2f(l1[i] & ~127); s2v[i] = s2f(l2[i] & ~127); }
        int c0[16], c1[16], c2[16], cx[2];
        { int cnt = 0;
#pragma unroll
          for (int a = 0; a < 16; ++a)
#pragma unroll
            for (int b = 0; b < 16; ++b)
                if ((a + 1) * (b + 1) <= 16) { const int key = (f2s(s1f[a] + s2v[b]) & ~255) | (a << 4) | b;
                    if (cnt < 16) c0[cnt] = key; else if (cnt < 32) c1[cnt - 16] = key; else if (cnt < 48) c2[cnt - 32] = key; else cx[cnt - 48] = key;
                    ++cnt; } }
        sort16_desc(c0); sort16_desc(c1); sort16_desc(c2);
        int m01[16], l3[16];
        merge16(m01, c0, c1); merge16(l3, m01, c2);
        ins16(l3, cx[0]); ins16(l3, cx[1]);
#define PK4(L, q) ((unsigned)(L[4 * (q)] & 127) | ((unsigned)(L[4 * (q) + 1] & 127) << 8) | ((unsigned)(L[4 * (q) + 2] & 127) << 16) | ((unsigned)(L[4 * (q) + 3] & 127) << 24))
        const unsigned pa0 = PK4(l1, 0), pa1 = PK4(l1, 1), pa2 = PK4(l1, 2), pa3 = PK4(l1, 3), pb0 = PK4(l2, 0), pb1 = PK4(l2, 1), pb2 = PK4(l2, 2), pb3 = PK4(l2, 3);
#undef PK4
        float ex[16]; unsigned eidx[16]; float sum = 0.f;
        int l3max = l3[0];
#pragma unroll
        for (int i = 1; i < 16; ++i) l3max = max(l3max, l3[i]);
        const float vmax = s2f(l3max & ~255);
#pragma unroll
        for (int r = 0; r < 16; ++r) { const int bits = l3[r]; const int a = (bits >> 4) & 15, b = bits & 15;
            const unsigned i1 = (sel4(pa0, pa1, pa2, pa3, a >> 2) >> (8 * (a & 3))) & 127u, i2 = (sel4(pb0, pb1, pb2, pb3, b >> 2) >> (8 * (b & 3))) & 127u;
            eidx[r] = i1 * 128u + i2; ex[r] = __expf(s2f(bits & ~255) - vmax); sum += ex[r]; }
        const float inv = 1.0f / sum;
        const size_t item = item0 + (size_t)lane * istride;
        u32x4 o0, o1;
        o0.x = eidx[0] | (eidx[1] << 16); o0.y = eidx[2] | (eidx[3] << 16); o0.z = eidx[4] | (eidx[5] << 16); o0.w = eidx[6] | (eidx[7] << 16);
        o1.x = eidx[8] | (eidx[9] << 16); o1.y = eidx[10] | (eidx[11] << 16); o1.z = eidx[12] | (eidx[13] << 16); o1.w = eidx[14] | (eidx[15] << 16);
        *(u32x4*)(IDX + item * 16) = o0; *(u32x4*)(IDX + item * 16 + 8) = o1;
#pragma unroll
        for (int q = 0; q < 4; ++q) { f32x4 g = {ex[4 * q] * inv, ex[4 * q + 1] * inv, ex[4 * q + 2] * inv, ex[4 * q + 3] * inv}; *(f32x4*)(GATE + item * 16 + 4 * q) = g; }
    }
}

__device__ __forceinline__ void cvt_usl(const float* U, bf16* USL, int gw, int NGW, int lane) {
    for (int row = gw; row < DEPTH * 16384; row += NGW) {
        const int layer = row >> 14, e = row & 16383;
        const float* src = U + (size_t)row * 1024;
#pragma unroll
        for (int hf = 0; hf < 2; ++hf) { const int col = hf * 512 + 8 * lane; const f32x4 a = *(const f32x4*)(src + col), b = *(const f32x4*)(src + col + 4);
            u32x4 o; o.x = pk2(a[0], a[1]); o.y = pk2(a[2], a[3]); o.z = pk2(b[0], b[1]); o.w = pk2(b[2], b[3]);
            *(u32x4*)(USL + (((size_t)layer * 16 + (col >> 6)) * 16384 + e) * 64 + (col & 63)) = o; }
    }
}
#ifndef U_FP8
#define U_FP8 1
#endif
constexpr float U8_SCALE = 512.0f, U8_INV = 1.0f / 512.0f;
__device__ __forceinline__ void cvt_usl8(const float* U, unsigned char* USL8, int nrows, int gw, int NGW, int lane) {
    for (int row = gw; row < nrows; row += NGW) {
        const int layer = row >> 14, e = row & 16383;
        const float* src = U + (size_t)row * 1024 + 16 * lane;
        u32x4 o;
#pragma unroll
        for (int q = 0; q < 4; ++q) { const f32x4 a = *(const f32x4*)(src + 4 * q); int w = 0;
            w = __builtin_amdgcn_cvt_pk_fp8_f32(a[0] * U8_SCALE, a[1] * U8_SCALE, w, false); w = __builtin_amdgcn_cvt_pk_fp8_f32(a[2] * U8_SCALE, a[3] * U8_SCALE, w, true); o[q] = (unsigned)w; }
        *(u32x4*)(USL8 + (((size_t)layer * 8 + (lane >> 3)) * 16384 + e) * 128 + 16 * (lane & 7)) = o;
    }
}
template <int CTRL> __device__ __forceinline__ float dpp_g(float v) { return __int_as_float(__builtin_amdgcn_update_dpp(0, __float_as_int(v), CTRL, 0xf, 0xf, true)); }
__device__ __forceinline__ void peer_s1_f8(const bf16* H, const unsigned short* IDXP, const unsigned char* USL8, unsigned short* PART, int bid, int G, int wave, int lane) {
    typedef _Float16 h16x2 __attribute__((ext_vector_type(2)));
    const int s = bid & 7, rank = bid >> 3, nr = (G - s + 7) >> 3;
    const int g8 = lane >> 3, li8 = lane & 7;
    const bool c0 = li8 & 1, c1 = li8 & 2, c2 = li8 & 4;
    const int i0 = (c2 ? 8 : 0) + (c0 ? 4 : 0) + (c1 ? 2 : 0);
    const unsigned char* ub = USL8 + (size_t)s * 16384 * 128;
    const unsigned lo16 = 16u * li8, seven = 7u;
    const int t0s = (rank * 8 + wave) * 2, stride = nr * 16;
    const int nit = (T - t0s + stride - 1) / stride;
    if (nit <= 0) return;
    u32x4 iw[2][2], hr[2][2], d[2][16]; h16x2 hp[8];
#define S1_LOAD_IH(q, tok) { const size_t t_ = (size_t)(tok); \
        iw[q][0] = *(const u32x4*)(IDXP + t_ * 128 + g8 * 16); iw[q][1] = *(const u32x4*)(IDXP + t_ * 128 + g8 * 16 + 8); \
        hr[q][0] = *(const u32x4*)(H + t_ * DM + 128 * s + 16 * li8); hr[q][1] = *(const u32x4*)(H + t_ * DM + 128 * s + 16 * li8 + 8); }
#define S1_ROWS(dst, src) _Pragma("unroll") for (int i = 0; i < 16; ++i) { const unsigned wd = (src)[i >> 3][(i >> 1) & 3]; unsigned off; \
        if (i & 1) asm("v_lshlrev_b32_sdwa %0, %1, %2 dst_sel:DWORD dst_unused:UNUSED_PAD src0_sel:DWORD src1_sel:WORD_1" : "=v"(off) : "v"(seven), "v"(wd)); \
        else       asm("v_lshlrev_b32_sdwa %0, %1, %2 dst_sel:DWORD dst_unused:UNUSED_PAD src0_sel:DWORD src1_sel:WORD_0" : "=v"(off) : "v"(seven), "v"(wd)); \
        dst[i] = *(const u32x4*)(ub + (off | lo16)); }
    S1_LOAD_IH(0, t0s) S1_LOAD_IH(1, t0s + 1)
    S1_ROWS(d[0], iw[0])
#pragma unroll
    for (int q = 0; q < 2; ++q) asm volatile("" :: "v"(iw[q][0]), "v"(iw[q][1]), "v"(hr[q][0]), "v"(hr[q][1]));
#pragma unroll
    for (int i = 0; i < 16; ++i) asm volatile("" :: "v"(d[0][i]));
    for (int j = 0; j < nit; ++j) {
        const int t0 = t0s + j * stride, tn = (j + 1 < nit) ? t0 + stride : t0;
#pragma unroll
        for (int p = 0; p < 2; ++p) {
#pragma unroll
            for (int q = 0; q < 4; ++q) { const unsigned w0 = hr[p][0][q], w1 = hr[p][1][q];
                hp[q] = (h16x2){(_Float16)bflo(w0), (_Float16)bfhi(w0)}; hp[4 + q] = (h16x2){(_Float16)bflo(w1), (_Float16)bfhi(w1)}; }
            __builtin_amdgcn_sched_barrier(0);
            S1_LOAD_IH(p, tn + p)
            S1_ROWS(d[p ^ 1], iw[p ^ 1])
            __builtin_amdgcn_sched_barrier(0);
            float a[16];
#pragma unroll
            for (int i = 0; i < 16; ++i) { float a0 = 0.f, a1 = 0.f;
#pragma unroll
                for (int q = 0; q < 4; ++q) { const unsigned dw = d[p][i][q];
                    a0 = __builtin_amdgcn_fdot2(__builtin_amdgcn_cvt_scalef32_pk_f16_fp8((int)dw, 1.0f, false), hp[2 * q], a0, false);
                    a1 = __builtin_amdgcn_fdot2(__builtin_amdgcn_cvt_scalef32_pk_f16_fp8((int)dw, 1.0f, true), hp[2 * q + 1], a1, false); }
                a[i] = a0 + a1; }
            float b[8], c[4], r[2];
#pragma unroll
            for (int k = 0; k < 8; ++k) { const float keep = c2 ? a[8 + k] : a[k], send = c2 ? a[k] : a[8 + k]; b[k] = keep + dpp_g<0x141>(send); }
#pragma unroll
            for (int k = 0; k < 4; ++k) { const float keep = c0 ? b[4 + k] : b[k], send = c0 ? b[k] : b[4 + k]; c[k] = keep + dpp_g<0xB1>(send); }
#pragma unroll
            for (int k = 0; k < 2; ++k) { const float keep = c1 ? c[2 + k] : c[k], send = c1 ? c[k] : c[2 + k]; r[k] = keep + dpp_g<0x4E>(send); }
            { const h16x2 pr = {(_Float16)r[0], (_Float16)r[1]}; *(unsigned*)(PART + ((size_t)s * T + t0 + p) * 128 + g8 * 16 + i0) = __builtin_bit_cast(unsigned, pr); }
        }
    }
#undef S1_LOAD_IH
#undef S1_ROWS
}
__device__ __forceinline__ void cvt_vsl(const float* V, bf16* VSL, int gw, int NGW, int lane) {
    for (int it = gw; it < DEPTH * 1024 * 4; it += NGW) {
        const int qq = it & 3, eb = (it >> 2) & 1023, layer = it >> 12;
        const float* src = V + ((size_t)layer * 16384 + eb * 16) * 1024 + qq * 256 + 4 * lane;
        u32x2 w[16];
#pragma unroll
        for (int e = 0; e < 16; ++e) { const f32x4 a = *(const f32x4*)(src + (size_t)e * 1024); w[e].x = pk2(a[0], a[1]); w[e].y = pk2(a[2], a[3]); }
        u32x4* dst = (u32x4*)(VSL + (((size_t)layer * 256 + qq * 64 + lane) * 16384 + eb * 16) * 4);
#pragma unroll
        for (int e = 0; e < 8; ++e) { u32x4 o = {w[2 * e].x, w[2 * e].y, w[2 * e + 1].x, w[2 * e + 1].y}; dst[e] = o; }
    }
}
#ifndef V_FP8
#define V_FP8 1
#endif
constexpr float V8_SCALE = 64.0f, V8_INV = 1.0f / 64.0f;
constexpr float A8_SCALE = 64.0f, A8_INV = 1.0f / 64.0f;
__device__ __forceinline__ void cvt_vsl8(const float* V, unsigned char* VSL8, int gw, int NGW, int lane) {
    for (int it = gw; it < DEPTH * 1024 * 2; it += NGW) {
        const int hf = it & 1, eb = (it >> 1) & 1023, layer = it >> 11;
        const float* src = V + ((size_t)layer * 16384 + eb * 16) * 1024 + hf * 512 + 8 * lane;
        u32x2 w[16];
#pragma unroll
        for (int e = 0; e < 16; ++e) { const f32x4 a = *(const f32x4*)(src + (size_t)e * 1024), b = *(const f32x4*)(src + (size_t)e * 1024 + 4); int w0 = 0, w1 = 0;
            w0 = __builtin_amdgcn_cvt_pk_fp8_f32(a[0] * V8_SCALE, a[1] * V8_SCALE, w0, false); w0 = __builtin_amdgcn_cvt_pk_fp8_f32(a[2] * V8_SCALE, a[3] * V8_SCALE, w0, true);
            w1 = __builtin_amdgcn_cvt_pk_fp8_f32(b[0] * V8_SCALE, b[1] * V8_SCALE, w1, false); w1 = __builtin_amdgcn_cvt_pk_fp8_f32(b[2] * V8_SCALE, b[3] * V8_SCALE, w1, true);
            w[e].x = (unsigned)w0; w[e].y = (unsigned)w1; }
        u32x4* dst = (u32x4*)(VSL8 + (((size_t)layer * 128 + hf * 64 + lane) * 16384 + eb * 16) * 8);
#pragma unroll
        for (int e = 0; e < 8; ++e) { u32x4 o = {w[2 * e].x, w[2 * e].y, w[2 * e + 1].x, w[2 * e + 1].y}; dst[e] = o; }
    }
}
__device__ __forceinline__ void peer_s1(const bf16* H, const unsigned short* IDXP, const bf16* USL, float* PART, int bid, int G, int wave, int lane) {
    const int x = bid & 7, rank = bid >> 3, nr = (G - x + 7) >> 3;
    const int g8 = lane >> 3, li8 = lane & 7;
    for (int sp = 0; sp < 2; ++sp) {
        const int s = 2 * x + sp;
        const unsigned char* ub = (const unsigned char*)(USL + (size_t)s * 16384 * 64) + li8 * 16;
        for (int t0 = (rank * 8 + wave) * 2; t0 < T; t0 += nr * 16) {
            u32x4 hs[2], iw[2][2], d[2][16];
#pragma unroll
            for (int tk = 0; tk < 2; ++tk) { const size_t t = (size_t)t0 + tk;
                hs[tk] = *(const u32x4*)(H + t * DM + 64 * s + 8 * li8);
                iw[tk][0] = *(const u32x4*)(IDXP + t * 128 + g8 * 16); iw[tk][1] = *(const u32x4*)(IDXP + t * 128 + g8 * 16 + 8); }
#pragma unroll
            for (int tk = 0; tk < 2; ++tk)
#pragma unroll
                for (int i = 0; i < 16; ++i) { const unsigned wd = iw[tk][i >> 3][(i >> 1) & 3]; const unsigned e = (i & 1) ? (wd >> 16) : (wd & 0xffffu);
                    d[tk][i] = *(const u32x4*)(ub + (size_t)(e * 128u)); }
#pragma unroll
            for (int tk = 0; tk < 2; ++tk) {
                float a[16];
#pragma unroll
                for (int i = 0; i < 16; ++i) { float v = dot2(d[tk][i][0], hs[tk][0], 0.f); v = dot2(d[tk][i][1], hs[tk][1], v); v = dot2(d[tk][i][2], hs[tk][2], v); a[i] = dot2(d[tk][i][3], hs[tk][3], v); }
                float b[8], c[4], r[2];
#pragma unroll
                for (int k = 0; k < 8; ++k) { const float keep = (li8 & 1) ? a[2 * k + 1] : a[2 * k], send = (li8 & 1) ? a[2 * k] : a[2 * k + 1]; b[k] = keep + __shfl_xor(send, 1); }
#pragma unroll
                for (int k = 0; k < 4; ++k) { const float keep = (li8 & 2) ? b[2 * k + 1] : b[2 * k], send = (li8 & 2) ? b[2 * k] : b[2 * k + 1]; c[k] = keep + __shfl_xor(send, 2); }
#pragma unroll
                for (int k = 0; k < 2; ++k) { const float keep = (li8 & 4) ? c[2 * k + 1] : c[2 * k], send = (li8 & 4) ? c[2 * k] : c[2 * k + 1]; r[k] = keep + __shfl_xor(send, 4); }
                float* pp = PART + ((size_t)s * T + t0 + tk) * 128 + g8 * 16 + li8;
                pp[0] = r[0]; pp[8] = r[1];
            }
        }
    }
}
template <int RB> __device__ __forceinline__ void peer_reduce_blk(const unsigned short* PART, const float* GA, unsigned char* AO, size_t i0, size_t nthr) {
    typedef _Float16 h16x2_r __attribute__((ext_vector_type(2)));
    u32x4 w[RB][8]; f32x4 g0[RB], g1[RB];
#pragma unroll
    for (int u = 0; u < RB; ++u) { const size_t i = i0 + u * nthr;
#pragma unroll
        for (int sl = 0; sl < 8; ++sl) w[u][sl] = ((const u32x4*)(PART + (size_t)sl * T * 128))[i];
        g0[u] = ((const f32x4*)GA)[2 * i]; g1[u] = ((const f32x4*)GA)[2 * i + 1]; }
#pragma unroll
    for (int u = 0; u < RB; ++u) { const size_t i = i0 + u * nthr;
        float sum[8] = {0.f, 0.f, 0.f, 0.f, 0.f, 0.f, 0.f, 0.f};
#pragma unroll
        for (int sl = 0; sl < 8; ++sl)
#pragma unroll
            for (int q = 0; q < 4; ++q) { const unsigned wq = w[u][sl][q]; const h16x2_r p = __builtin_bit_cast(h16x2_r, wq); sum[2 * q] += (float)p[0]; sum[2 * q + 1] += (float)p[1]; }
        float g[8];
#pragma unroll
        for (int e = 0; e < 4; e += 2) {
            const pg8::f32x2 ga = pg8::gelu_pk((pg8::f32x2){U_FP8 ? sum[e] * U8_INV : sum[e], U_FP8 ? sum[e + 1] * U8_INV : sum[e + 1]});
            const pg8::f32x2 gb = pg8::gelu_pk((pg8::f32x2){U_FP8 ? sum[4 + e] * U8_INV : sum[4 + e], U_FP8 ? sum[5 + e] * U8_INV : sum[5 + e]});
            g[e] = g0[u][e] * ga[0]; g[e + 1] = g0[u][e + 1] * ga[1]; g[4 + e] = g1[u][e] * gb[0]; g[5 + e] = g1[u][e + 1] * gb[1]; }
        u32x2 o;
#pragma unroll
        for (int h = 0; h < 2; ++h) { int wv = 0;
            wv = __builtin_amdgcn_cvt_pk_fp8_f32(fminf(fmaxf(g[4 * h] * A8_SCALE, -448.f), 448.f), fminf(fmaxf(g[4 * h + 1] * A8_SCALE, -448.f), 448.f), wv, false);
            wv = __builtin_amdgcn_cvt_pk_fp8_f32(fminf(fmaxf(g[4 * h + 2] * A8_SCALE, -448.f), 448.f), fminf(fmaxf(g[4 * h + 3] * A8_SCALE, -448.f), 448.f), wv, true);
            if (h == 0) o.x = (unsigned)wv; else o.y = (unsigned)wv; }
        ((u32x2*)AO)[i] = o; }
}
__device__ __forceinline__ void peer_reduce(const unsigned short* PART, const float* GA, unsigned char* AO, size_t gtid, size_t nthr) {
    size_t i = gtid;
    for (; i + nthr < (size_t)T * 16; i += 2 * nthr) peer_reduce_blk<2>(PART, GA, AO, i, nthr);
    for (; i < (size_t)T * 16; i += nthr) peer_reduce_blk<1>(PART, GA, AO, i, nthr);
}
template <int CTRL> __device__ __forceinline__ float dpp_f(float v) { return __int_as_float(__builtin_amdgcn_update_dpp(0, __float_as_int(v), CTRL, 0xf, 0xf, true)); }
template <int ABL, bool CV> __device__ __forceinline__ void peer_s2_f8(const unsigned short* IDXP, const unsigned char* AV, const unsigned char* VSL8, const bf16* Xin, bf16* Xout, LAS unsigned char* lds, int bid, int G, int tid, int wave, int lane,
                                                                     const float* cvU, unsigned char* cvUo, const float* cvP, bf16* cvPo, unsigned char* cvDead) {
    typedef _Float16 h16x2 __attribute__((ext_vector_type(2)));
    const int tk = lane >> 2, jj = lane & 3;
    const bool b0 = jj & 1, b1 = jj & 2;
    constexpr int NIT = T / 2 / 16;
    const unsigned three = 3u, lbase = 0u;
    constexpr size_t STEP = (size_t)16 * NWV * 128;
    const int e0 = (b0 ? 4 : 0) + (b1 ? 2 : 0);
    for (int cb = bid; cb < 256; cb += G) {
        const int x = cb & 7, k = cb >> 3, c = 16 * x + (k & 15), th = k >> 4;
        __syncthreads();
        { const u32x4* src = (const u32x4*)(VSL8 + (size_t)c * 16384 * 8);
          for (int i = tid; i < 8192; i += NTHR) ((LAS u32x4*)lds)[i] = src[i]; }
        __syncthreads();
        const size_t tb = (size_t)th * (T / 2) + 16 * wave;
        const unsigned short* ip = IDXP + (tb + tk) * 128 + 32 * jj; const unsigned char* ap = AV + (tb + tk) * 128 + 32 * jj;
        const size_t xo = (tb + tk) * DM + 8 * c + e0;
        u32x4 iw[2][4], aw[2][2]; u32x2 vb[2][8];
#define S2_LOOKUPS(dst, src) _Pragma("unroll") for (int m = 0; m < 8; ++m) { const unsigned wd = (src)[m >> 1]; unsigned ad; \
            if (m & 1) asm("v_lshlrev_b32_sdwa %0, %1, %2 dst_sel:DWORD dst_unused:UNUSED_PAD src0_sel:DWORD src1_sel:WORD_1" : "=v"(ad) : "v"(three), "v"(wd)); \
            else       asm("v_lshlrev_b32_sdwa %0, %1, %2 dst_sel:DWORD dst_unused:UNUSED_PAD src0_sel:DWORD src1_sel:WORD_0" : "=v"(ad) : "v"(three), "v"(wd)); \
            dst[m] = *(const LAS u32x2*)(uintptr_t)(ad + lbase); }
#pragma unroll
        for (int q = 0; q < 2; ++q) {
#pragma unroll
            for (int u = 0; u < 4; ++u) iw[q][u] = *(const u32x4*)(ip + q * STEP + 8 * u);
            aw[q][0] = *(const u32x4*)(ap + q * STEP); aw[q][1] = *(const u32x4*)(ap + q * STEP + 16); }
        S2_LOOKUPS(vb[0], iw[0][0])
        constexpr int NU4 = 16384 * 4, NP4 = T;
        const int gwv = bid * NWV + wave;
#define S2_CV_SRC(i_) ((i_) < NU4 ? cvU + (size_t)(i_) * 256 + 4 * lane : cvP + (size_t)(((i_) < NU4 + NP4 ? (i_) : NU4 + NP4 - 1) - NU4) * 256 + 4 * lane)
        f32x4 cv = {0.f, 0.f, 0.f, 0.f};
        if (CV) { cv = *(const f32x4*)S2_CV_SRC(gwv); asm volatile("" :: "v"(cv)); }
#pragma unroll
        for (int q = 0; q < 2; ++q) {
#pragma unroll
            for (int u = 0; u < 4; ++u) asm volatile("" :: "v"(iw[q][u]));
            asm volatile("" :: "v"(aw[q][0]), "v"(aw[q][1])); }
        constexpr int NST = NIT / NWV;
        for (int s = 0; s < NST; s += 2) {
#pragma unroll
            for (int p = 0; p < 2; ++p) {
                const int sc = s + p;
                const size_t o2 = (size_t)(sc + 2 < NST ? sc + 2 : NST - 1) * STEP;
                const unsigned xw = *(const unsigned*)(Xin + xo + (size_t)sc * 16 * NWV * DM);
                h16x2 acc[4] = {{0, 0}, {0, 0}, {0, 0}, {0, 0}};
#pragma unroll
                for (int u = 0; u < 4; ++u) {
                    if (u < 3) { S2_LOOKUPS(vb[(u + 1) & 1], iw[p][u + 1]) } else { S2_LOOKUPS(vb[0], iw[p ^ 1][0]) }
                    if (u == 2) {
#pragma unroll
                        for (int u2 = 0; u2 < 4; ++u2) iw[p][u2] = *(const u32x4*)(ip + o2 + 8 * u2); }
                    __builtin_amdgcn_sched_barrier(0);
#pragma unroll
                    for (int m = 0; m < 8; ++m) { const u32x2 v = vb[u & 1][m];
                        const unsigned awd = aw[p][u >> 1][2 * (u & 1) + (m >> 2)];
                        const h16x2 ap2 = (m & 2) ? __builtin_amdgcn_cvt_scalef32_pk_f16_fp8((int)awd, 1.0f, true) : __builtin_amdgcn_cvt_scalef32_pk_f16_fp8((int)awd, 1.0f, false); const h16x2 am2 = (m & 1) ? (h16x2){ap2[1], ap2[1]} : (h16x2){ap2[0], ap2[0]};
                        acc[0] += am2 * __builtin_amdgcn_cvt_scalef32_pk_f16_fp8((int)v.x, 1.0f, false); acc[1] += am2 * __builtin_amdgcn_cvt_scalef32_pk_f16_fp8((int)v.x, 1.0f, true);
                        acc[2] += am2 * __builtin_amdgcn_cvt_scalef32_pk_f16_fp8((int)v.y, 1.0f, false); acc[3] += am2 * __builtin_amdgcn_cvt_scalef32_pk_f16_fp8((int)v.y, 1.0f, true); }
                    __builtin_amdgcn_sched_barrier(0);
                }
                aw[p][0] = *(const u32x4*)(ap + o2); aw[p][1] = *(const u32x4*)(ap + o2 + 16);
                float v8[8];
#pragma unroll
                for (int q = 0; q < 4; ++q) { v8[2 * q] = (float)acc[q][0]; v8[2 * q + 1] = (float)acc[q][1]; }
                float w4[4], w2[2];
#pragma unroll
                for (int k2 = 0; k2 < 4; ++k2) { const float keep = b0 ? v8[4 + k2] : v8[k2], send = b0 ? v8[k2] : v8[4 + k2]; w4[k2] = keep + dpp_f<0xB1>(send); }
#pragma unroll
                for (int k2 = 0; k2 < 2; ++k2) { const float keep = b1 ? w4[2 + k2] : w4[k2], send = b1 ? w4[k2] : w4[2 + k2]; w2[k2] = keep + dpp_f<0x4E>(send); }
                *(unsigned*)(Xout + xo + (size_t)sc * 16 * NWV * DM) = pk2(bflo(xw) + w2[0] * (V8_INV * A8_INV), bfhi(xw) + w2[1] * (V8_INV * A8_INV));
                if (CV && p == 0) {
                    const int i = (s >> 1) * (NWV * 256) + gwv;
                    const bool isu = i < NU4, isp = !isu && i < NU4 + NP4;
                    { const int row = i >> 2, quarter = i & 3; int w = 0;
                      w = __builtin_amdgcn_cvt_pk_fp8_f32(cv[0] * U8_SCALE, cv[1] * U8_SCALE, w, false); w = __builtin_amdgcn_cvt_pk_fp8_f32(cv[2] * U8_SCALE, cv[3] * U8_SCALE, w, true);
                      unsigned char* du = isu ? cvUo + ((size_t)(quarter * 2) * 16384 + row) * 128 : cvDead;
                      *(unsigned*)(du + (isu ? (size_t)(lane >> 5) * 16384 * 128 + ((4 * lane) & 127) : (size_t)(4 * lane))) = (unsigned)w; }
                    { u32x2 w; w.x = pk2(cv[0], cv[1]); w.y = pk2(cv[2], cv[3]);
                      unsigned char* dp = isp ? (unsigned char*)(cvPo + (size_t)(i - NU4) * 256) : cvDead + 1024;
                      *(u32x2*)(dp + 8 * lane) = w; }
                    cv = *(const f32x4*)S2_CV_SRC(i + NWV * 256);
                }
            }
        }
#undef S2_LOOKUPS
#undef S2_CV_SRC
    }
}

template <int RB> __device__ __forceinline__ void qk_norm_rope_blk(bf16* buf, int ld, int nh, const float (&gn)[8], const float* COS, const float* SIN, float scale, int base0, int bstep, int sub, int li, bool dry) {
    u32x4 raw[RB]; f32x4 cw[RB][2], sw[RB][2];
    const int jb = (li & 1) * 8;
#pragma unroll
    for (int u = 0; u < RB; ++u) { const int pr = base0 + u * bstep + sub, t = pr / nh, h = pr - t * nh;
        raw[u] = *(const u32x4*)(buf + (size_t)t * ld + h * 128 + 8 * li);
        cw[u][0] = *(const f32x4*)(COS + (size_t)t * 16 + jb); cw[u][1] = *(const f32x4*)(COS + (size_t)t * 16 + jb + 4);
        sw[u][0] = *(const f32x4*)(SIN + (size_t)t * 16 + jb); sw[u][1] = *(const f32x4*)(SIN + (size_t)t * 16 + jb + 4); }
#pragma unroll
    for (int u = 0; u < RB; ++u) { const int pr = base0 + u * bstep + sub, t = pr / nh, h = pr - t * nh;
        bf16* p = buf + (size_t)t * ld + h * 128 + 8 * li;
        float x[8];
#pragma unroll
        for (int q = 0; q < 4; ++q) { x[2 * q] = bflo(raw[u][q]); x[2 * q + 1] = bfhi(raw[u][q]); }
        float ss = 0.f;
#pragma unroll
        for (int e = 0; e < 8; ++e) ss += x[e] * x[e];
        ss += __shfl_xor(ss, 1); ss += __shfl_xor(ss, 2); ss += __shfl_xor(ss, 4); ss += __shfl_xor(ss, 8);
        const float rstd = 1.0f / sqrtf(ss * (1.0f / 128.0f) + EPS);
        float yv[8], part[8];
#pragma unroll
        for (int e = 0; e < 8; ++e) yv[e] = x[e] * rstd * gn[e];
#pragma unroll
        for (int e = 0; e < 8; ++e) part[e] = __shfl_xor(yv[e], 2);
        if (li < 4) {
#pragma unroll
            for (int e = 0; e < 8; ++e) { const float c = cw[u][e >> 2][e & 3], sn = sw[u][e >> 2][e & 3];
                yv[e] = (li < 2) ? (yv[e] * c - part[e] * sn) : (yv[e] * c + part[e] * sn); } }
        u32x4 o; o.x = pk2(yv[0] * scale, yv[1] * scale); o.y = pk2(yv[2] * scale, yv[3] * scale); o.z = pk2(yv[4] * scale, yv[5] * scale); o.w = pk2(yv[6] * scale, yv[7] * scale);
        if (!dry) *(u32x4*)p = o; else asm volatile("" :: "v"(o)); }
}
__device__ __forceinline__ void qk_norm_rope(bf16* buf, int ld, int nh, const float* gain, const float* COS, const float* SIN, float scale, int gw, int NGW, int lane, bool dry) {
    const int sub = lane >> 4, li = lane & 15;
    float gn[8];
#pragma unroll
    for (int e = 0; e < 8; ++e) gn[e] = gain[8 * li + e];
    const int total = T * nh;
    int base = gw * 4;
    for (; base + 3 * NGW * 4 < total; base += 4 * NGW * 4) qk_norm_rope_blk<4>(buf, ld, nh, gn, COS, SIN, scale, base, NGW * 4, sub, li, dry);
    for (; base < total; base += NGW * 4) qk_norm_rope_blk<1>(buf, ld, nh, gn, COS, SIN, scale, base, NGW * 4, sub, li, dry);
}

constexpr int KROW = 272;
__device__ __forceinline__ s16x4 vtr(const LAS unsigned char* p) { typedef short v4i16_t __attribute__((ext_vector_type(4))); return __builtin_bit_cast(s16x4, __builtin_amdgcn_ds_read_tr16_b64_v4i16((LAS v4i16_t*)p)); }
__device__ __forceinline__ void att_decode(int it, int nblk, int& b, int& g, int& kvh, int& d, int& r, int& n) {
    int tile16, gb;
    if ((nblk & 7) == 0) { const int x = it & 7, q = it >> 3, P = 16 * x + q / 48, tt = q % 48; b = P >> 3; kvh = P & 7; g = tt >> 4; tile16 = tt & 15; }
    else { tile16 = it & 15; gb = it >> 7; kvh = (it >> 4) & 7; g = gb % 3; b = gb / 3; }
    if (g == 0) { d = 1; r = 0; n = tile16; } else if (g == 1) { d = 4; r = tile16 & 3; n = tile16 >> 2; } else { d = 16; r = tile16; n = 0; }
}
__device__ __forceinline__ float rows_sum(float v) {
    { const unsigned u = __float_as_uint(v); const auto r = __builtin_amdgcn_permlane16_swap(u, u, false, false); v = __uint_as_float(r[0]) + __uint_as_float(r[1]); }
    { const unsigned u = __float_as_uint(v); const auto r = __builtin_amdgcn_permlane32_swap(u, u, false, false); v = __uint_as_float(r[0]) + __uint_as_float(r[1]); }
    return v; }
__device__ __forceinline__ float rows_max(float v) {
    { const unsigned u = __float_as_uint(v); const auto r = __builtin_amdgcn_permlane16_swap(u, u, false, false); v = __builtin_amdgcn_fmed3f(__uint_as_float(r[0]), __uint_as_float(r[1]), INFINITY); }
    { const unsigned u = __float_as_uint(v); const auto r = __builtin_amdgcn_permlane32_swap(u, u, false, false); v = __builtin_amdgcn_fmed3f(__uint_as_float(r[0]), __uint_as_float(r[1]), INFINITY); }
    return v; }
__device__ __forceinline__ void attn_phase(bf16* QO, const bf16* KB, const bf16* VB, float* LSE, const float* qgain, const float* COS, const float* SIN, LAS unsigned char* lds, int tid, int wave, int lane, int bid, int nblk, bool dry) {
    LAS unsigned char* Ks = lds; LAS unsigned char* Vs = lds + 256 * KROW;
    const int li = lane & 15, G = lane >> 4;
    const int tw = (wave & ~1) < 6 ? (wave & ~1) : 6;
    const float NEG = -INFINITY;
    const int qi = wave * 16 + li;
    const int kq = 16 * tw + 4 * G - qi;
    const LAS unsigned char* kbase = Ks + (16 * tw + li) * KROW + 16 * G;
    const LAS unsigned char* vbase = Vs + (16 * tw + 4 * G + (li >> 2)) * KROW + 8 * (li & 3);
    constexpr int NT = BATCH * 3 * 8 * 16;
    u32x4 kreg[8], vreg[8]; bf16x8 nqf[4]; f32x4 ncs[2], nsn[2];
    f32x4 qg[4][2];
    constexpr float QSC = 0.08838834764831845f * 1.4426950408889634f;
#pragma unroll
    for (int s4 = 0; s4 < 4; ++s4) { qg[s4][0] = *(const f32x4*)(qgain + 32 * s4 + 8 * G) * QSC; qg[s4][1] = *(const f32x4*)(qgain + 32 * s4 + 8 * G + 4) * QSC; }
#define ATT_FETCH(B_, G_, KVH_, D_, R_, N_) do { \
        const unsigned kvo_ = (unsigned)((tid >> 4) * (D_)) * 2048u + (unsigned)(tid & 15) * 16u, vvo_ = kvo_ + (unsigned)((const unsigned char*)VB - (const unsigned char*)KB);     \
        _Pragma("unroll") for (int i_ = 0; i_ < 8; ++i_) { int s0_ = (((N_) - 1) * 128 + 32 * i_) * (D_) + (R_); if (s0_ < 0) s0_ += 128 * (D_);     \
            const size_t ub_ = ((size_t)(B_) * SEQ + s0_) * 2048 + (size_t)(KVH_) * 256; \
            kreg[i_] = *(const u32x4*)((const unsigned char*)KB + ub_ + kvo_); vreg[i_] = *(const u32x4*)((const unsigned char*)KB + ub_ + vvo_); } \
        { const size_t tq0_ = (size_t)(B_) * SEQ + (size_t)((N_) * 128 * (D_) + (R_)); \
          const unsigned char* qb_ = (const unsigned char*)QO + (tq0_ * 3072 + (size_t)(G_) * 1024 + (size_t)(KVH_) * 128) * 2; const unsigned qo_ = (unsigned)(qi * (D_)) * 6144u + 16u * G; \
          _Pragma("unroll") for (int s4_ = 0; s4_ < 4; ++s4_) nqf[s4_] = *(const bf16x8*)(qb_ + qo_ + 64 * s4_); \
          const unsigned co_ = (unsigned)(qi * (D_)) * 64u + 32u * (G & 1); const unsigned char* cb_ = (const unsigned char*)COS + tq0_ * 64; const unsigned char* sb_ = (const unsigned char*)SIN + tq0_ * 64; \
          ncs[0] = *(const f32x4*)(cb_ + co_); ncs[1] = *(const f32x4*)(cb_ + co_ + 16); nsn[0] = *(const f32x4*)(sb_ + co_); nsn[1] = *(const f32x4*)(sb_ + co_ + 16); } } while (0)
    int it = bid, b, g, kvh, d, r, n;
    if (it < NT) { att_decode(it, nblk, b, g, kvh, d, r, n); ATT_FETCH(b, g, kvh, d, r, n); }
    for (; it < NT; it += nblk) {
        const size_t rowb = (size_t)b * SEQ;
        const bool has_prev = n > 0;
        const int ltmin = has_prev ? 0 : (8 - tw);
        if (!(PROBE_ABL == 21 && dry)) asm volatile("s_waitcnt lgkmcnt(0)\n\ts_barrier" ::: "memory");
#pragma unroll
        for (int i = 0; i < 8; ++i) { const int rr = (tid >> 4) + 32 * i;
            *(LAS u32x4*)(Ks + rr * KROW + (tid & 15) * 16) = kreg[i]; *(LAS u32x4*)(Vs + rr * KROW + (tid & 15) * 16) = vreg[i]; }
        const int sq = (n * 128 + qi) * d + r;
        bf16x8 qf[4];
#pragma unroll
        for (int s4 = 0; s4 < 4; ++s4) qf[s4] = nqf[s4];
        float cs[8], sn[8];
#pragma unroll
        for (int e = 0; e < 8; ++e) { cs[e] = ncs[e >> 2][e & 3]; sn[e] = nsn[e >> 2][e & 3]; }
        const int cg = g, ckvh = kvh, cn = n, cd = d, cr = r;
        __builtin_amdgcn_sched_barrier(0);
        { const int itn = it + nblk; int itc = itn < NT ? itn : it; if (PROBE_ABL == 20 && dry) itc = bid; att_decode(itc, nblk, b, g, kvh, d, r, n); ATT_FETCH(b, g, kvh, d, r, n); }
        __builtin_amdgcn_sched_barrier(0);
        {
            float qv[4][8]; float ss = 0.f;
#pragma unroll
            for (int s4 = 0; s4 < 4; ++s4) { const u32x4 w = __builtin_bit_cast(u32x4, qf[s4]);
#pragma unroll
                for (int q = 0; q < 4; ++q) { qv[s4][2 * q] = bflo(w[q]); qv[s4][2 * q + 1] = bfhi(w[q]); ss += qv[s4][2 * q] * qv[s4][2 * q] + qv[s4][2 * q + 1] * qv[s4][2 * q + 1]; } }
            ss = rows_sum(ss);
            const float rs = __builtin_amdgcn_rsqf(ss * (1.0f / 128.0f) + EPS);
#pragma unroll
            for (int s4 = 0; s4 < 4; ++s4) { const f32x4 g0 = qg[s4][0], g1 = qg[s4][1];
#pragma unroll
                for (int e = 0; e < 4; ++e) { qv[s4][e] *= rs * g0[e]; qv[s4][4 + e] *= rs * g1[e]; } }
#pragma unroll
            for (int e = 0; e < 8; ++e) { const float part = __shfl_xor(qv[0][e], 32);
                qv[0][e] = (G < 2) ? (qv[0][e] * cs[e] - part * sn[e]) : (qv[0][e] * cs[e] + part * sn[e]); }
#pragma unroll
            for (int s4 = 0; s4 < 4; ++s4) { u32x4 w;
#pragma unroll
                for (int q = 0; q < 4; ++q) w[q] = pk2(qv[s4][2 * q], qv[s4][2 * q + 1]);
                qf[s4] = __builtin_bit_cast(bf16x8, w); }
        }
        if (!(PROBE_ABL == 21 && dry)) asm volatile("s_waitcnt lgkmcnt(0)\n\ts_barrier" ::: "memory");
        f32x4 st[10];
        int kqv = kq; asm volatile("" : "+v"(kqv));
#pragma unroll
        for (int lt = 0; lt < 10; ++lt) {
            const int rel = tw - wave + lt;
            if (lt >= ltmin && rel >= 0 && rel <= 8) {
                f32x4 acc = {0.f, 0.f, 0.f, 0.f};
#pragma unroll
                for (int s4 = 0; s4 < 4; ++s4) { const bf16x8 kf = *(const LAS bf16x8*)(kbase + lt * 16 * KROW + 64 * s4); acc = __builtin_amdgcn_mfma_f32_16x16x32_bf16(kf, qf[s4], acc, 0, 0, 0); }
                if (rel == 0 || rel == 8) {
#pragma unroll
                    for (int rg = 0; rg < 4; ++rg) { if ((unsigned)(kqv + 16 * lt + rg) > 128u) acc[rg] = NEG; } }
                st[lt] = acc;
            } else { st[lt] = (f32x4){NEG, NEG, NEG, NEG}; }
        }
        float m = NEG;
#pragma unroll
        for (int lt = 0; lt < 10; ++lt)
#pragma unroll
            for (int rg = 0; rg < 4; ++rg) m = __builtin_amdgcn_fmed3f(m, st[lt][rg], INFINITY);
        m = rows_max(m);
        float l;
        { typedef float f32x2s __attribute__((ext_vector_type(2)));
          const f32x2s m2 = {m, m}; f32x2s la = {0.f, 0.f};
#pragma unroll
          for (int lt = 0; lt < 10; ++lt)
#pragma unroll
            for (int h2 = 0; h2 < 2; ++h2) { f32x2s sv = {st[lt][2 * h2], st[lt][2 * h2 + 1]}; sv = sv - m2;
                f32x2s pv = {__builtin_amdgcn_exp2f(sv[0]), __builtin_amdgcn_exp2f(sv[1])}; st[lt][2 * h2] = pv[0]; st[lt][2 * h2 + 1] = pv[1]; la += pv; }
          l = la[0] + la[1]; }
        l = rows_sum(l);
        f32x4 o[8];
#pragma unroll
        for (int dt = 0; dt < 8; ++dt) o[dt] = (f32x4){0.f, 0.f, 0.f, 0.f};
#pragma unroll
        for (int pp = 0; pp < 5; ++pp) {
            if (2 * pp >= ltmin) {
                u32x4 aw; aw.x = pk2(st[2 * pp][0], st[2 * pp][1]); aw.y = pk2(st[2 * pp][2], st[2 * pp][3]); aw.z = pk2(st[2 * pp + 1][0], st[2 * pp + 1][1]); aw.w = pk2(st[2 * pp + 1][2], st[2 * pp + 1][3]);
                const bf16x8 pf = __builtin_bit_cast(bf16x8, aw);
#pragma unroll
                for (int dt = 0; dt < 8; ++dt) { const s16x4 lo = vtr(vbase + 2 * pp * 16 * KROW + 32 * dt), hi = vtr(vbase + (2 * pp + 1) * 16 * KROW + 32 * dt);
                    const bf16x8 vf = {lo[0], lo[1], lo[2], lo[3], hi[0], hi[1], hi[2], hi[3]};
                    o[dt] = __builtin_amdgcn_mfma_f32_16x16x32_bf16(vf, pf, o[dt], 0, 0, 0); }
            }
        }
        const float inv = __builtin_amdgcn_rcpf(l);
        bf16* op = (bf16*)((unsigned char*)QO + ((rowb + (size_t)(cn * 128 * cd + cr)) * 3072 + (size_t)cg * 1024 + (size_t)ckvh * 128) * 2 + ((unsigned)(qi * cd) * 6144u + 8u * G));
#pragma unroll
        for (int dt = 0; dt < 8; ++dt) { u32x2 ov; ov.x = pk2(o[dt][0] * inv, o[dt][1] * inv); ov.y = pk2(o[dt][2] * inv, o[dt][3] * inv);
            if (!dry) *(u32x2*)(op + 16 * dt) = ov; else asm volatile("" :: "v"(ov)); }
        if (G == 0 && !dry) LSE[((size_t)cg * T + rowb + sq) * 8 + ckvh] = m + __builtin_amdgcn_logf(l);
    }
#undef ATT_FETCH
}
__device__ __forceinline__ void merge_phase(const bf16* QO, const float* LSE, bf16* Hout, int b0, int bstep, int bend, int lane) {
    const int sub = lane >> 4, li = lane & 15;
    for (int base = b0; base < bend; base += bstep) {
        const int pr = base + sub, t = pr >> 3, h = pr & 7;
        const float l0 = LSE[((size_t)0 * T + t) * 8 + h], l1 = LSE[((size_t)1 * T + t) * 8 + h], l2 = LSE[((size_t)2 * T + t) * 8 + h];
        const float mx = fmaxf(l0, fmaxf(l1, l2));
        float w0 = exp2f(l0 - mx), w1 = exp2f(l1 - mx), w2 = exp2f(l2 - mx);
        const float inv = 1.0f / (w0 + w1 + w2); w0 *= inv; w1 *= inv; w2 *= inv;
        const bf16* p = QO + (size_t)t * 3072 + h * 128 + 8 * li;
        const u32x4 a = *(const u32x4*)p, bq = *(const u32x4*)(p + 1024), c = *(const u32x4*)(p + 2048);
        u32x4 o;
#pragma unroll
        for (int q = 0; q < 4; ++q) o[q] = pk2(w0 * bflo(a[q]) + w1 * bflo(bq[q]) + w2 * bflo(c[q]), w0 * bfhi(a[q]) + w1 * bfhi(bq[q]) + w2 * bfhi(c[q]));
        *(u32x4*)(Hout + (size_t)t * DM + h * 128 + 8 * li) = o;
    }
}

#define RLX_AGENT __ATOMIC_RELAXED, __HIP_MEMORY_SCOPE_AGENT
#define XB_TMO      128
#define XB_XCNT(j)  (256  + 64 * (j))
#define XB_XSUB(j)  (1280 + 64 * (j))
#define XB_XGEN(j)  (2304 + 64 * (j))
#define XB_TOP      3328
#define XB_TOPGEN   3392
#define XCD_BAR_WORDS 3456
#define XB_LSUB(j)  (3520 + 64 * (j))
#define XB_LGEN(j)  (4544 + 64 * (j))
#define XB_SPIN_CAP (1u << 20)

__device__ __forceinline__ unsigned xb_ld(unsigned* p)              { return __hip_atomic_load(p, __ATOMIC_RELAXED, __HIP_MEMORY_SCOPE_AGENT); }
__device__ __forceinline__ unsigned xb_add(unsigned* p, unsigned v) { return __hip_atomic_fetch_add(p, v, __ATOMIC_RELAXED, __HIP_MEMORY_SCOPE_AGENT); }
__device__ __forceinline__ unsigned xb_xcc_id() { return (unsigned)__builtin_amdgcn_s_getreg((3 << 11) | 20) & 0xFu; }
#define XB_SPIN(cond, bar) do { unsigned _sp = 0; while (cond) { __builtin_amdgcn_s_sleep(1); \
    if ((++_sp & 255u) == 0u) { if (xb_ld(&(bar)[XB_TMO])) break; if (_sp > XB_SPIN_CAP) { atomicAdd(&(bar)[XB_TMO], 1u); break; } } } } while (0)

struct XcdBarrier {
    unsigned* bar; unsigned x;
    volatile LAS unsigned* st;
};

__device__ __forceinline__ XcdBarrier xcd_barrier_post(unsigned* bar, volatile LAS unsigned* st) {
    XcdBarrier b; b.bar = bar; b.x = xb_xcc_id(); b.st = st;
    if (threadIdx.x == 0) { st[4] = xb_add(&bar[XB_XCNT(b.x)], 1u); st[2] = blockIdx.x; }
    return b;
}
__device__ __forceinline__ void xcd_barrier_complete(unsigned* bar, unsigned x, unsigned& nloc, unsigned& nx, unsigned& even32, unsigned& xi) {
    const unsigned G = gridDim.x * gridDim.y * gridDim.z;
    unsigned sum, cnt, mine, n32 = 0u, below = 0u, sp = 0u;
    for (;;) {
        sum = 0u; cnt = 0u; mine = 0u; n32 = 0u; below = 0u;
#pragma unroll
        for (unsigned j = 0; j < 16; ++j) { const unsigned c = xb_ld(&bar[XB_XCNT(j)]); sum += c; cnt += (c > 0u) ? 1u : 0u; mine = (j == x) ? c : mine; n32 += (c == 32u) ? 1u : 0u; below += (j < x && c > 0u) ? 1u : 0u; }
        if (sum == G) break;
        __builtin_amdgcn_s_sleep(1);
        if ((++sp & 255u) == 0u) { if (xb_ld(&bar[XB_TMO])) break; if (sp > XB_SPIN_CAP) { atomicAdd(&bar[XB_TMO], 1u); break; } }
    }
    nloc = mine > 0u ? mine : 1u; nx = cnt > 0u ? cnt : 1u;
    even32 = (G == 256u && cnt == 8u && n32 == 8u) ? 1u : 0u;
    xi = below;
}

__device__ __forceinline__ void xcd_barrier(const XcdBarrier& b) {
    asm volatile("s_waitcnt vmcnt(0)" ::: "memory");
    __syncthreads();
    if (threadIdx.x == 0) {
        unsigned* bar = b.bar;
        __builtin_amdgcn_s_waitcnt(0);
        unsigned nloc = b.st[0], nx = b.st[1];
        if (nloc == 0u) { unsigned even32, xi; xcd_barrier_complete(bar, b.x, nloc, nx, even32, xi); b.st[0] = nloc; b.st[1] = nx;
            if (even32) { b.st[2] = b.st[4] * 8u + xi; b.st[3] = 1u; } }
        const unsigned old = xb_add(&bar[XB_XSUB(b.x)], 1u);
        const unsigned gen = old / nloc;
        if (old + 1u == (gen + 1u) * nloc) {
            __builtin_amdgcn_fence(__ATOMIC_RELEASE, "agent");
            asm volatile("s_waitcnt vmcnt(0)" ::: "memory");
            const unsigned og = xb_add(&bar[XB_TOP], 1u);
            const unsigned tg = og / nx;
            if (og + 1u == (tg + 1u) * nx) xb_add(&bar[XB_TOPGEN], 1u);
            else XB_SPIN(xb_ld(&bar[XB_TOPGEN]) == tg, bar);
            __builtin_amdgcn_fence(__ATOMIC_ACQUIRE, "agent");
            xb_add(&bar[XB_XGEN(b.x)], 1u);
            asm volatile("s_waitcnt vmcnt(0)" ::: "memory");
        } else {
            XB_SPIN(xb_ld(&bar[XB_XGEN(b.x)]) == gen, bar);
            __builtin_amdgcn_fence(__ATOMIC_ACQUIRE, "agent");
            asm volatile("s_waitcnt vmcnt(0)" ::: "memory");
        }
    }
    __syncthreads();
}

__device__ __forceinline__ void xcd_barrier_local(const XcdBarrier& b) {
    if (b.st[3] == 0u) { xcd_barrier(b); return; }
    asm volatile("s_waitcnt vmcnt(0)" ::: "memory");
    __syncthreads();
    if (threadIdx.x == 0) {
        unsigned* bar = b.bar;
        __builtin_amdgcn_s_waitcnt(0);
        const unsigned old = xb_add(&bar[XB_LSUB(b.x)], 1u);
        const unsigned gen = old / 32u;
        if (old + 1u == (gen + 1u) * 32u) xb_add(&bar[XB_LGEN(b.x)], 1u);
        else XB_SPIN(xb_ld(&bar[XB_LGEN(b.x)]) == gen, bar);
        __builtin_amdgcn_fence(__ATOMIC_ACQUIRE, "agent");
        asm volatile("s_waitcnt vmcnt(0)" ::: "memory");
    }
    __syncthreads();
}

#ifndef PHMASK
#define PHMASK 0xffffffffffffffffull
#endif
#ifndef PROBE_PRO
#define PROBE_PRO 0
#endif
#ifndef PROBE_ABL
#define PROBE_ABL 0
#endif
#ifndef PROBE_MASK
#define PROBE_MASK 0ull
#endif
struct Args { const void* in[22]; float* out; unsigned char* ws; int ph_lo, ph_hi; };
__device__ __forceinline__ const void* karg(int byte_off) {
    asm volatile("" : "+s"(byte_off));
    typedef const unsigned char __attribute__((address_space(4))) cuc4;
    cuc4* kp = (cuc4*)__builtin_amdgcn_kernarg_segment_ptr();
    return *(const void* const __attribute__((address_space(4)))*)(kp + byte_off);
}
#define INF(i) ((const float*)karg(8 * (i)))
#define XP() ((float*)karg(176))
#define WSB() ((unsigned char*)karg(184))

__global__ void __launch_bounds__(NTHR, 2) yoco_fwd(Args args) {
    extern __shared__ __attribute__((aligned(16))) unsigned char lds_raw[];
    LAS unsigned char* lds = (LAS unsigned char*)lds_raw;
    if ((unsigned)(uintptr_t)lds != 0u) __builtin_trap();
    volatile LAS unsigned* bst = (volatile LAS unsigned*)(lds + LDS_BYTES - 64);
    if (threadIdx.x < 16) bst[threadIdx.x] = 0u;
    __syncthreads();
    const XcdBarrier bar = xcd_barrier_post((unsigned*)WSB(), bst);
    __syncthreads();
    int ph = 0; const int lo = args.ph_lo, hi = args.ph_hi;
#define TIDS int tid_l = threadIdx.x, bid_l = __builtin_amdgcn_readfirstlane((int)bst[2]), G_l = gridDim.x; asm volatile("" : "+v"(tid_l), "+s"(bid_l), "+s"(G_l)); \
             const int tid = tid_l, bid = bid_l, lane = tid & 63, wave = __builtin_amdgcn_readfirstlane(tid >> 6); const int G = G_l, gw = bid * NWV + wave, NGW = G * NWV; \
             const size_t gtid = (size_t)bid * NTHR + tid, nthr = (size_t)G * NTHR; (void)lane; (void)gw; (void)NGW; (void)gtid; (void)nthr; (void)bid;
#define XCD_RANGE const int xcls = (G >= 8) ? (bid & 7) : 0, xnwg = (G >= 8) ? ((G - xcls + 7) >> 3) : G, xrk = (G >= 8) ? (bid >> 3) : bid; \
                  const int xr0 = (G >= 8) ? xcls * (T / 8) : 0, xr1 = (G >= 8) ? xr0 + T / 8 : T, xlw = xrk * NWV + wave, xnw = xnwg * NWV; (void)xr1; (void)xlw; (void)xnw;
#define PH_BEGIN(id) if (((PHMASK >> (id)) & 1ull) && ph >= lo && ph < hi) { for (int rep = (int)((PROBE_MASK >> (id)) & 1ull); rep >= 0; --rep) { const bool dry = rep > 0; (void)dry; if (PROBE_MASK) __syncthreads(); TIDS unsigned char* ws = WSB(); (void)ws;
#ifndef PROBE_BAR
#define PROBE_BAR 0
#endif
#ifndef PROBE_SYNC
#define PROBE_SYNC 0
#endif
#define PH_END   if (PROBE_SYNC && dry) xcd_barrier(bar); } if (ph + 1 < hi) { xcd_barrier(bar); if (PROBE_BAR) { xcd_barrier(bar); xcd_barrier(bar); } } } ++ph;
#define PH_END_C(loc)   if (PROBE_SYNC && dry) xcd_barrier(bar); } if (ph + 1 < hi) { if (loc) xcd_barrier_local(bar); else xcd_barrier(bar); } } ++ph;

    PH_BEGIN(0)
#if U_FP8
#define CVT_U_CALL cvt_usl8(INF(17), ws + WS_UBF, (G == 256 ? 1 : DEPTH) * 16384, gw, NGW, lane);
#else
#define CVT_U_CALL cvt_usl(INF(17), (bf16*)(ws + WS_UBF), gw, NGW, lane);
#endif
#if V_FP8
#define CVT_V_CALL cvt_vsl8(INF(18), ws + WS_VBF, gw, NGW, lane);
#else
#define CVT_V_CALL cvt_vsl(INF(18), (bf16*)(ws + WS_VBF), gw, NGW, lane);
#endif
#define PRO_BODY \
    { \
        LAS float* scr = (LAS float*)(lds + wave * 8704); \
        bf16* WIN = (bf16*)(ws + WS_WIN); bf16* WOUT = (bf16*)(ws + WS_WOUT); bf16* WKV = (bf16*)(ws + WS_WKV); bf16* WQ = (bf16*)(ws + WS_WQ); bf16* WO = (bf16*)(ws + WS_WO); \
        bf16* WGATE = (bf16*)(ws + WS_WGATE); bf16* WPROJ = (bf16*)(ws + WS_WPROJ); \
 \
        constexpr int I_IN = 16 * 96, I_SQ = 16 * 32, I_KV = 16 * 64, I_PJ = 4 * 32; \
        constexpr int NITEMS = 2 * I_IN + 2 * I_SQ + I_KV + 2 * I_IN + 2 * I_SQ + 4 * I_SQ + 4 * I_PJ; \
        for (int it = gw; it < NITEMS; it += NGW) { \
            int r = it; \
            if (r < 2 * I_IN) { const int l = r / I_IN; transpose_item(INF(4) + (size_t)l * 1024 * 3072, 1024, 3072, WIN + (size_t)l * 3072 * 1024, 1, scr, r % I_IN, lane); continue; } r -= 2 * I_IN; \
            if (r < 2 * I_SQ) { const int l = r / I_SQ; transpose_item(INF(6) + (size_t)l * 1024 * 1024, 1024, 1024, WOUT + (size_t)l * 1024 * 1024, 0, scr, r % I_SQ, lane); continue; } r -= 2 * I_SQ; \
            if (r < I_KV) { transpose_item(INF(8), 1024, 2048, WKV, 0, scr, r, lane); continue; } r -= I_KV; \
            if (r < 2 * I_IN) { const int l = r / I_IN; transpose_item(INF(11) + (size_t)l * 1024 * 3072, 1024, 3072, WQ + (size_t)l * 3072 * 1024, 0, scr, r % I_IN, lane); continue; } r -= 2 * I_IN; \
            if (r < 2 * I_SQ) { const int l = r / I_SQ; transpose_item(INF(13) + (size_t)l * 1024 * 1024, 1024, 1024, WO + (size_t)l * 1024 * 1024, 0, scr, r % I_SQ, lane); continue; } r -= 2 * I_SQ; \
            if (r < 4 * I_SQ) { const int l = r / I_SQ; transpose_item(INF(20) + (size_t)l * 1024 * 1024, 1024, 1024, WGATE + (size_t)l * 1024 * 1024, 0, scr, r % I_SQ, lane); continue; } r -= 4 * I_SQ; \
            { const int l = r / I_PJ; transpose_item(INF(21) + (size_t)l * 256 * 1024, 256, 1024, WPROJ + (size_t)l * 1024 * 256, 0, scr, r % I_PJ, lane); } \
        } \
        for (int it = bid; it < 256; it += G) precombine_item(INF(15), INF(16), (bf16*)(ws + WS_WPQ), lds, it, tid, wave, lane); \
        CVT_U_CALL \
        CVT_V_CALL \
        cvt_bulk(INF(1), (bf16*)(ws + WS_PBF), (size_t)(G == 256 ? 1 : DEPTH) * T * 256 / 8, gtid, nthr); \
        { const int* pos_in = (const int*)karg(16); float* COS = (float*)(ws + WS_COS); float* SIN = (float*)(ws + WS_SIN); \
          const bool jfix = (nthr & 15) == 0; const double inv0 = exp(-(double)(gtid & 15) * (13.122363377404328 / 16.0));     \
          for (size_t i = gtid; i < (size_t)T * 16; i += nthr) { \
            const int t = (int)(i >> 4), j = (int)(i & 15); \
            const double inv = jfix ? inv0 : exp(-(double)j * (13.122363377404328 / 16.0)); \
            const double ang = (double)pos_in[t] * inv; const double nn = rint(ang * 0.15915494309189535); \
            double rr = fma(-nn, 6.283185307179586, ang); rr = fma(-nn, 2.4492935982947064e-16, rr); \
            const float rf = (float)rr; COS[i] = cosf(rf); SIN[i] = sinf(rf); \
          } } \
        { XCD_RANGE norm_rows(INF(0), nullptr, nullptr, INF(3), (bf16*)(ws + WS_H), (bf16*)(ws + WS_X), xr0 + xlw, xnw, xr1, lane); } \
    }
    PRO_BODY
#if PROBE_PRO
    __syncthreads();
    PRO_BODY
#endif
    PH_END

    for (int layer = 0; layer < DEPTH; ++layer) {
        if (layer < 2) {
            PH_BEGIN(1)
            { pg8::Gemm g{(const bf16*)(ws + WS_H), (const bf16*)(ws + WS_WIN) + (size_t)layer * 3072 * 1024, T, 3072, 1024}; pg8::StaticOrder S; S.init(T, 3072, G, bid);
              pg8::EpiWin E{(bf16*)(ws + WS_BIG), (bf16*)(ws + WS_BIG + 64 * MiB)};
              pg8::gemm_phase<pg8::EpiWin, pg8::StaticOrder, true, true>(lds, g, S, E); }
            PH_END_C(true)
            PH_BEGIN(2)
            { XCD_RANGE conv_gate((const bf16*)(ws + WS_BIG), (const bf16*)(ws + WS_BIG + 64 * MiB), INF(5) + (size_t)layer * 3 * 1024, (bf16*)(ws + WS_BIG + 128 * MiB), (size_t)xr0 * 128 + (size_t)xrk * NTHR + tid, (size_t)xnwg * NTHR, (size_t)xr1 * 128); }
            PH_END_C(true)
            PH_BEGIN(3)
            { bf16* X = (bf16*)(ws + WS_X);
              pg8::Gemm g{(const bf16*)(ws + WS_BIG + 128 * MiB), (const bf16*)(ws + WS_WOUT) + (size_t)layer * 1024 * 1024, T, 1024, 1024}; pg8::StaticOrder S; S.init(T, 1024, G, bid);
              pg8::EpiResB E{X, dry ? (bf16*)(ws + WS_K) : X};
              pg8::gemm_phase<pg8::EpiResB, pg8::StaticOrder, true, true>(lds, g, S, E); }
            PH_END_C(true)
        } else {
            PH_BEGIN(4)
            { pg8::Gemm g{(const bf16*)(ws + WS_H), (const bf16*)(ws + WS_WQ) + (size_t)(layer - 2) * 3072 * 1024, T, 3072, 1024}; pg8::StaticOrder S; S.init(T, 3072, G, bid);
              pg8::EpiBf16<0> E{(bf16*)(ws + WS_BIG), 3072, nullptr, 0, 0, 1.f};
              pg8::gemm_phase<pg8::EpiBf16<0>, pg8::StaticOrder, true, true>(lds, g, S, E); }
            PH_END_C(true)
            PH_BEGIN(6)
            attn_phase((bf16*)(ws + WS_BIG), (const bf16*)(ws + WS_K), (const bf16*)(ws + WS_V), (float*)(ws + WS_IDX), INF(12) + (size_t)(layer - 2) * 128, (const float*)(ws + WS_COS), (const float*)(ws + WS_SIN), lds, tid, wave, lane, bid, G, dry);
            PH_END_C(true)
            PH_BEGIN(7)
            { XCD_RANGE merge_phase((const bf16*)(ws + WS_BIG), (const float*)(ws + WS_IDX), (bf16*)(ws + WS_H), xr0 * 8 + xlw * 4, xnw * 4, xr1 * 8, lane); }
            PH_END_C(true)
            PH_BEGIN(8)
            { bf16* X = (bf16*)(ws + WS_X);
              pg8::Gemm g{(const bf16*)(ws + WS_H), (const bf16*)(ws + WS_WO) + (size_t)(layer - 2) * 1024 * 1024, T, 1024, 1024}; pg8::StaticOrder S; S.init(T, 1024, G, bid);
              pg8::EpiResB E{X, dry ? (bf16*)(ws + WS_BIG) : X};
              pg8::gemm_phase<pg8::EpiResB, pg8::StaticOrder, true, true>(lds, g, S, E); }
            PH_END_C(true)
        }
        PH_BEGIN(9)
        { XCD_RANGE norm_rows(nullptr, (const bf16*)(ws + WS_X), nullptr, INF(14) + (size_t)layer * 1024, (bf16*)(ws + WS_H), nullptr, xr0 + xlw, xnw, xr1, lane); }
        PH_END_C(layer < 2)
        PH_BEGIN(10)
        { pg8::Gemm g{(const bf16*)(ws + WS_H), (const bf16*)(ws + WS_WPQ) + (size_t)layer * 2048 * 1024, T, 2048, 1024}; pg8::StaticOrder S; S.init(T, 2048, G, bid);
          pg8::EpiBf16<0> E{(bf16*)(ws + (layer < 2 ? WS_K : WS_BIG)), 2048, nullptr, 0, 0, 1.f};
          pg8::gemm_phase<pg8::EpiBf16<0>, pg8::StaticOrder, true, true>(lds, g, S, E);
          asm volatile("s_waitcnt vmcnt(0)" ::: "memory"); __syncthreads();
          int lane2 = threadIdx.x & 63, wave2 = wave, bid2 = bid; asm volatile("" : "+v"(lane2), "+s"(wave2), "+s"(bid2));
          unsigned char* ws2 = WSB();
          constexpr int NWG = (T / 256) * 8;
          const int nu = (NWG - bid2 + G - 1) / G;
          for (int jb = wave2; jb < 4 * nu; jb += NWV) {
              int wgid = (jb >> 2) * G + bid2; { const int q = NWG / 8, xcd = wgid % 8, off = wgid / 8; wgid = xcd * q + off; }
              const int nig = pg8::WGM * 8, gid = wgid / nig, fm = gid * pg8::WGM, pm = fm + ((wgid % nig) % pg8::WGM), pn = (wgid % nig) / pg8::WGM;
              const size_t t0 = (size_t)pm * 256 + 64 * (jb & 3);
              topk_job((const bf16*)(ws2 + (layer < 2 ? WS_K : WS_BIG)) + t0 * 2048 + pn * 256, 2048, t0 * 8 + pn, 8, (unsigned short*)(ws2 + WS_IDX), (float*)(ws2 + WS_GATE), lds + wave2 * 10240, lane2); } }
        PH_END
        PH_BEGIN(12)
#if U_FP8
        peer_s1_f8((const bf16*)(ws + WS_H), (const unsigned short*)(ws + WS_IDX), ws + WS_UBF + (size_t)layer * 16384 * 1024, (unsigned short*)(ws + WS_BIG), bid, G, wave, lane);
#else
        peer_s1((const bf16*)(ws + WS_H), (const unsigned short*)(ws + WS_IDX), (const bf16*)(ws + WS_UBF) + (size_t)layer * 16384 * 1024, (float*)(ws + WS_BIG), bid, G, wave, lane);
#endif
        PH_END
        PH_BEGIN(18)
        peer_reduce((const unsigned short*)(ws + WS_BIG), (const float*)(ws + WS_GATE), dry ? (unsigned char*)(ws + WS_PB) : (unsigned char*)(ws + WS_IDX + 8 * MiB), gtid, nthr);
        PH_END
        PH_BEGIN(19)
        { const bool cvn = (G == 256) && (layer + 1 < DEPTH);
          const float* cU = INF(17) + (size_t)(layer + 1) * 16384 * 1024; unsigned char* cUo = ws + WS_UBF + (size_t)(layer + 1) * 16384 * 1024;
          const float* cP = INF(1) + (size_t)(layer + 1) * T * 256; bf16* cPo = (bf16*)(ws + WS_PBF) + (size_t)(layer + 1) * T * 256;
          if (cvn) peer_s2_f8<0, true>((const unsigned short*)(ws + WS_IDX), (const unsigned char*)(ws + WS_IDX + 8 * MiB), ws + WS_VBF + (size_t)layer * 16384 * 1024, (const bf16*)(ws + WS_X), dry ? (bf16*)(ws + WS_BIG + 128 * MiB) : (bf16*)(ws + WS_X), lds, bid, G, tid, wave, lane, cU, cUo, cP, cPo, ws + WS_BIG + 200 * MiB);
          else peer_s2_f8<0, false>((const unsigned short*)(ws + WS_IDX), (const unsigned char*)(ws + WS_IDX + 8 * MiB), ws + WS_VBF + (size_t)layer * 16384 * 1024, (const bf16*)(ws + WS_X), dry ? (bf16*)(ws + WS_BIG + 128 * MiB) : (bf16*)(ws + WS_X), lds, bid, G, tid, wave, lane, nullptr, nullptr, nullptr, nullptr, nullptr); }
        PH_END
        PH_BEGIN(20)
        { XCD_RANGE norm_rows(nullptr, (const bf16*)(ws + WS_X), nullptr, INF(19) + (size_t)layer * 1024, (bf16*)(ws + WS_H), nullptr, xr0 + xlw, xnw, xr1, lane); }
        { pg8::Gemm g{(const bf16*)(ws + WS_PBF) + (size_t)layer * T * 256, (const bf16*)(ws + WS_WPROJ) + (size_t)layer * 1024 * 256, T, 1024, 256}; pg8::StaticOrder S; S.init(T, 1024, G, bid);
          pg8::EpiBf16<0> E{(bf16*)(ws + WS_PB), 1024, nullptr, 0, 0, 1.f};
          pg8::gemm_phase<pg8::EpiBf16<0>, pg8::StaticOrder, true, true>(lds, g, S, E); }
        PH_END_C(true)
        PH_BEGIN(13)
        { pg8::Gemm g{(const bf16*)(ws + WS_H), (const bf16*)(ws + WS_WGATE) + (size_t)layer * 1024 * 1024, T, 1024, 1024}; pg8::StaticOrder S; S.init(T, 1024, G, bid);
          bf16* X = (bf16*)(ws + WS_X);
          pg8::EpiPleB E{X, dry ? (bf16*)(ws + WS_BIG) : X, (const bf16*)(ws + WS_PB), (layer == DEPTH - 1) ? (dry ? (float*)(ws + WS_BIG) : XP()) : nullptr};
          pg8::gemm_phase<pg8::EpiPleB, pg8::StaticOrder, true, true>(lds, g, S, E); }
        PH_END_C(true)
        if (layer < 3) {
            PH_BEGIN(14)
            { const float* gn = (layer == 0) ? (INF(3) + 1024) : (layer == 1) ? INF(7) : (INF(10) + 1024);
              { XCD_RANGE norm_rows(nullptr, (const bf16*)(ws + WS_X), nullptr, gn, (bf16*)(ws + WS_H), nullptr, xr0 + xlw, xnw, xr1, lane); } }
            PH_END_C(true)
        }
        if (layer == 1) {
            PH_BEGIN(15)
            { pg8::Gemm g{(const bf16*)(ws + WS_H), (const bf16*)(ws + WS_WKV), T, 2048, 1024}; pg8::StaticOrder S; S.init(T, 2048, G, bid);
              pg8::EpiBf16<0> E{(bf16*)(ws + WS_K), 1024, nullptr, 1024, (size_t)(WS_V - WS_K) / 2, 1.f};
              pg8::gemm_phase<pg8::EpiBf16<0>, pg8::StaticOrder, true, true>(lds, g, S, E); }
            PH_END
            PH_BEGIN(16)
            qk_norm_rope((bf16*)(ws + WS_K), 1024, 8, INF(9), (const float*)(ws + WS_COS), (const float*)(ws + WS_SIN), 1.0f, gw, NGW, lane, dry);
            { XCD_RANGE norm_rows(nullptr, (const bf16*)(ws + WS_X), nullptr, INF(10), (bf16*)(ws + WS_H), nullptr, xr0 + xlw, xnw, xr1, lane); }
            PH_END
        }
    }
#undef PH_BEGIN
#undef PH_END
#undef PH_END_C
}

#ifndef MK_PER_PHASE
#define MK_PER_PHASE 0
#endif
extern "C" void kernel_launch(void* const* d_in, const int* in_sizes, int n_in, void* d_out, int out_size, void* d_ws, size_t ws_size, hipStream_t stream) {
    static int grid = 0;
    if (grid == 0) {
        if (n_in != 22 || out_size != T * DM || ws_size < WS_END) { fprintf(stderr, "kernel_launch: unexpected problem (n_in %d, out %d, ws %zu)\n", n_in, out_size, ws_size); grid = -1; return; }
        int dev = 0, cus = 0, per_cu = 0;
        hipGetDevice(&dev); hipDeviceGetAttribute(&cus, hipDeviceAttributeMultiprocessorCount, dev);
        if (hipFuncSetAttribute((const void*)yoco_fwd, hipFuncAttributeMaxDynamicSharedMemorySize, LDS_BYTES) != hipSuccess) { fprintf(stderr, "kernel_launch: hipFuncSetAttribute failed\n"); grid = -1; return; }
        if (hipOccupancyMaxActiveBlocksPerMultiprocessor(&per_cu, (const void*)yoco_fwd, NTHR, LDS_BYTES) != hipSuccess || per_cu < 1) { fprintf(stderr, "kernel_launch: occupancy query says %d\n", per_cu); (void)hipGetLastError(); per_cu = 1; }
        grid = cus;
    }
    if (grid < 0) return;
    if (hipMemsetAsync(d_ws, 0, 32768, stream) != hipSuccess) { fprintf(stderr, "kernel_launch: memset failed\n"); return; }
    Args a{};
    for (int i = 0; i < 22; ++i) a.in[i] = d_in[i];
    a.out = (float*)d_out; a.ws = (unsigned char*)d_ws;
#if MK_PER_PHASE
    for (int p = 0; p < NPHASES; ++p) { a.ph_lo = p; a.ph_hi = p + 1; hipLaunchKernelGGL(yoco_fwd, dim3(grid), dim3(NTHR), LDS_BYTES, stream, a); }
#else
    a.ph_lo = 0; a.ph_hi = NPHASES;
    void* kargs[] = {&a};
    hipError_t e = hipLaunchCooperativeKernel((const void*)yoco_fwd, dim3(grid), dim3(NTHR), kargs, LDS_BYTES, stream);
    if (e != hipSuccess) fprintf(stderr, "kernel_launch: cooperative launch failed: %s (grid %d)\n", hipGetErrorString(e), grid);
#endif
}
```
